# Optimizing an MI355X kernel written in HIP

```python
import functools
import jax, jax.numpy as jnp
from jax import lax
import numpy as np

D_MODEL = 2048
BATCH = 2
SEQ = 4096
DEPTH = 1
DEC_BATCH = 8
DEC_SEQ = 16
PAST_LEN = 1024

CHUNK = 64
HEAD_DIM = 64
RWKV_WIDTH = D_MODEL // 2
FOX_WIDTH = D_MODEL - RWKV_WIDTH
RWKV_HEADS = RWKV_WIDTH // HEAD_DIM
FOX_HEADS = FOX_WIDTH // HEAD_DIM
DECAY_LORA = 64
AAA_LORA = 64
GATE_LORA = 160
RWKV_PROJ = 3 * RWKV_WIDTH + DECAY_LORA + AAA_LORA + GATE_LORA
FOX_PROJ = 3 * FOX_WIDTH + FOX_HEADS + FOX_WIDTH
P_TOTAL = RWKV_PROJ + FOX_PROJ
D_FF = 4 * D_MODEL
Q_BLOCK = 128
ALPHA = (2 * DEPTH) ** 0.25
BETA = (8 * DEPTH) ** -0.25
LN_EPS = 1e-5
GN_EPS = 64e-5
RMS_EPS = 1e-6
ATTN_SCALE = HEAD_DIM ** -0.5

kernel_name = 'hybrid_rwkv7_fox_stream_encoder'


def layer_norm(x, g, b):
    xf = x.astype(jnp.float32)
    mu = jnp.mean(xf, -1, keepdims=True)
    var = jnp.mean(jnp.square(xf - mu), -1, keepdims=True)
    return ((xf - mu) * lax.rsqrt(var + LN_EPS) * g + b).astype(x.dtype)


def token_shift(p, prev, mu):
    p_prev = jnp.concatenate([prev.astype(p.dtype), p[:, :-1]], axis=1)
    return p + (p_prev - p) * mu


def rwkv7_mixer(ps, s0, w0, w2, a0, a2, g2, k_k, k_a, r_k, lnx_g, lnx_b):
    B, T, _ = ps.shape
    f32 = jnp.float32
    o1, o2, o3 = RWKV_WIDTH, 2 * RWKV_WIDTH, 3 * RWKV_WIDTH
    o4 = o3 + DECAY_LORA
    o5 = o4 + AAA_LORA
    r, k, v = ps[..., :o1], ps[..., o1:o2], ps[..., o2:o3]
    xw, xa, xg = ps[..., o3:o4], ps[..., o4:o5], ps[..., o5:]
    hs = (B, T, RWKV_HEADS, HEAD_DIM)
    wlog = -jax.nn.softplus(-(w0 + jnp.tanh(xw) @ w2).astype(f32)) - 0.5
    decay = jnp.exp(-jnp.exp(wlog)).reshape(hs)
    a_lr = jax.nn.sigmoid((a0 + xa @ a2).astype(f32))
    g = jax.nn.sigmoid(xg) @ g2
    kk = (k * k_k).astype(f32).reshape(hs)
    kk = kk / jnp.maximum(jnp.sqrt(jnp.sum(kk * kk, -1, keepdims=True)), 1e-12)
    k_h = (k.astype(f32) * (1.0 + (a_lr - 1.0) * k_a)).reshape(hs)
    a_h = a_lr.reshape(hs)
    r_h = r.astype(f32).reshape(hs)
    v_h = v.astype(f32).reshape(hs)

    def step(S, inp):
        r_t, w_t, k_t, v_t, a_t, b_t = inp
        sa = jnp.einsum('bhvk,bhk->bhv', S, a_t)
        S = S * w_t[:, :, None, :] + sa[..., None] * b_t[:, :, None, :] + v_t[..., None] * k_t[:, :, None, :]
        return S, jnp.einsum('bhvk,bhk->bhv', S, r_t)

    seqs = tuple(jnp.moveaxis(z, 1, 0) for z in (r_h, decay, k_h, v_h, -kk, kk * a_h))
    s_final, y = lax.scan(step, s0.astype(f32), seqs)
    y = jnp.moveaxis(y, 0, 1)
    mu = jnp.mean(y, -1, keepdims=True)
    var = jnp.mean(jnp.square(y - mu), -1, keepdims=True)
    yn = ((y - mu) * lax.rsqrt(var + GN_EPS)).reshape(B, T, RWKV_WIDTH) * lnx_g + lnx_b
    bonus = jnp.sum(r_h * k_h * r_k, -1, keepdims=True) * v_h
    out = (yn + bonus.reshape(B, T, RWKV_WIDTH)) * g
    return out.astype(ps.dtype), s_final


def fox_prompt_attention(q, k, v, logf):
    B, T, H, Dh = q.shape
    nb = T // Q_BLOCK
    f32 = jnp.float32
    c = jnp.cumsum(logf, axis=1)
    cT = jnp.moveaxis(c, -1, 1)
    kf = k.astype(f32)
    vf = v.astype(f32)
    qb = (q.astype(f32) * ATTN_SCALE).reshape(B, nb, Q_BLOCK, H, Dh).transpose(1, 0, 2, 3, 4)
    cb = c.reshape(B, nb, Q_BLOCK, H).transpose(1, 0, 3, 2)
    kpos = jnp.arange(T)

    def block(args):
        i, q_i, c_i = args
        qpos = i * Q_BLOCK + jnp.arange(Q_BLOCK)
        s = jnp.einsum('bqhd,bkhd->bhqk', q_i, kf) + (c_i[..., :, None] - cT[..., None, :])
        s = jnp.where(kpos[None, :] <= qpos[:, None], s, -jnp.inf)
        p = jax.nn.softmax(s, axis=-1)
        return jnp.einsum('bhqk,bkhd->bqhd', p, vf)

    o = lax.map(block, (jnp.arange(nb), qb, cb))
    return o.transpose(1, 0, 2, 3, 4).reshape(B, T, H, Dh)


def fox_sample_attention(q, k, v, logf, cache_k, cache_v, cache_logf):
    B, T, H, Dh = q.shape
    P = cache_k.shape[1]
    f32 = jnp.float32
    k_all = jnp.concatenate([cache_k.astype(f32), k.astype(f32)], axis=1)
    v_all = jnp.concatenate([cache_v.astype(f32), v.astype(f32)], axis=1)
    c = jnp.cumsum(jnp.concatenate([cache_logf.astype(f32), logf], axis=1), axis=1)
    cT = jnp.moveaxis(c, -1, 1)
    s = jnp.einsum('bqhd,bkhd->bhqk', q.astype(f32) * ATTN_SCALE, k_all) + (cT[..., P:, None] - cT[..., None, :])
    qpos = P + jnp.arange(T)
    kpos = jnp.arange(P + T)
    s = jnp.where(kpos[None, :] <= qpos[:, None], s, -jnp.inf)
    p = jax.nn.softmax(s, axis=-1)
    return jnp.einsum('bhqk,bkhd->bqhd', p, v_all)


def hybrid_layer(x, shift_prev, s0, fox_attn, w_in, rwkv_mu, rwkv_w0, rwkv_w2, rwkv_a0, rwkv_a2, rwkv_g2,
                 rwkv_k_k, rwkv_k_a, rwkv_r_k, rwkv_lnx_g, rwkv_lnx_b, fox_b_f, fox_out_g, w_o,
                 ln1_g, ln1_b, w_up, w_down, ln2_g, ln2_b):
    B, T, _ = x.shape
    f32 = jnp.float32
    proj = x @ w_in
    p_rwkv = proj[..., :RWKV_PROJ]
    p_fox = proj[..., RWKV_PROJ:]
    ps = token_shift(p_rwkv, shift_prev, rwkv_mu)
    y_r, s_new = rwkv7_mixer(ps, s0, rwkv_w0, rwkv_w2, rwkv_a0, rwkv_a2, rwkv_g2,
                             rwkv_k_k, rwkv_k_a, rwkv_r_k, rwkv_lnx_g, rwkv_lnx_b)
    hs = (B, T, FOX_HEADS, HEAD_DIM)
    q = p_fox[..., :FOX_WIDTH].reshape(hs)
    k = p_fox[..., FOX_WIDTH:2 * FOX_WIDTH].reshape(hs)
    v = p_fox[..., 2 * FOX_WIDTH:3 * FOX_WIDTH].reshape(hs)
    f_logit = p_fox[..., 3 * FOX_WIDTH:3 * FOX_WIDTH + FOX_HEADS]
    og = p_fox[..., 3 * FOX_WIDTH + FOX_HEADS:]
    logf = jax.nn.log_sigmoid((f_logit + fox_b_f).astype(f32))
    o = fox_attn(q, k, v, logf)
    o = o * lax.rsqrt(jnp.mean(jnp.square(o), -1, keepdims=True) + RMS_EPS)
    y_f = (o.reshape(B, T, FOX_WIDTH) * fox_out_g * jax.nn.sigmoid(og.astype(f32))).astype(x.dtype)
    mix = jnp.concatenate([y_r, y_f], axis=-1) @ w_o
    h = layer_norm(ALPHA * x + mix, ln1_g, ln1_b)
    ffn = jnp.square(jax.nn.relu(h @ w_up)) @ w_down
    out = layer_norm(ALPHA * h + ffn, ln2_g, ln2_b)
    return out, k, v, logf, s_new, p_rwkv[:, -1:]


def setup_inputs(seed: int = 0) -> dict:
    key = jax.random.key(seed)
    ks = iter(jax.random.split(key, 40))
    f32 = jnp.float32

    def nrm(shape, scale):
        return scale * jax.random.normal(next(ks), shape, f32)

    w0_base = jnp.tile(jnp.linspace(-6.0, -1.0, HEAD_DIM, dtype=f32), RWKV_HEADS)
    return {
        'x_prompt': nrm((BATCH, SEQ, D_MODEL), 1.0),
        'x_sample': nrm((DEC_BATCH, DEC_SEQ, D_MODEL), 1.0),
        'cache_fox_k': nrm((DEPTH, DEC_BATCH, PAST_LEN, FOX_HEADS, HEAD_DIM), 1.0),
        'cache_fox_v': nrm((DEPTH, DEC_BATCH, PAST_LEN, FOX_HEADS, HEAD_DIM), 1.0),
        'cache_fox_logf': jax.nn.log_sigmoid(3.0 + nrm((DEPTH, DEC_BATCH, PAST_LEN, FOX_HEADS), 0.5)),
        'state_rwkv_wkv': nrm((DEPTH, DEC_BATCH, RWKV_HEADS, HEAD_DIM, HEAD_DIM), 0.3),
        'state_rwkv_shift': nrm((DEPTH, DEC_BATCH, 1, RWKV_PROJ), 1.0),
        'w_in': nrm((DEPTH, D_MODEL, P_TOTAL), D_MODEL ** -0.5),
        'rwkv_mu': jax.random.uniform(next(ks), (DEPTH, RWKV_PROJ), f32),
        'rwkv_w0': w0_base + nrm((DEPTH, RWKV_WIDTH), 0.1),
        'rwkv_w2': nrm((DEPTH, DECAY_LORA, RWKV_WIDTH), 0.1 * DECAY_LORA ** -0.5),
        'rwkv_a0': nrm((DEPTH, RWKV_WIDTH), 0.1),
        'rwkv_a2': nrm((DEPTH, AAA_LORA, RWKV_WIDTH), 0.5 * AAA_LORA ** -0.5),
        'rwkv_g2': nrm((DEPTH, GATE_LORA, RWKV_WIDTH), GATE_LORA ** -0.5),
        'rwkv_k_k': 0.85 + nrm((DEPTH, RWKV_WIDTH), 0.02),
        'rwkv_k_a': 1.0 + nrm((DEPTH, RWKV_WIDTH), 0.02),
        'rwkv_r_k': -0.04 + nrm((DEPTH, RWKV_HEADS, HEAD_DIM), 0.01),
        'rwkv_lnx_g': 1.0 + nrm((DEPTH, RWKV_WIDTH), 0.02),
        'rwkv_lnx_b': nrm((DEPTH, RWKV_WIDTH), 0.02),
        'fox_b_f': 3.0 + nrm((DEPTH, FOX_HEADS), 0.5),
        'fox_out_g': 1.0 + nrm((DEPTH, FOX_WIDTH), 0.02),
        'w_o': nrm((DEPTH, D_MODEL, D_MODEL), BETA * D_MODEL ** -0.5),
        'ln1_g': 1.0 + nrm((DEPTH, D_MODEL), 0.02),
        'ln1_b': nrm((DEPTH, D_MODEL), 0.02),
        'w_up': nrm((DEPTH, D_MODEL, D_FF), D_MODEL ** -0.5),
        'w_down': nrm((DEPTH, D_FF, D_MODEL), BETA * D_FF ** -0.5),
        'ln2_g': 1.0 + nrm((DEPTH, D_MODEL), 0.02),
        'ln2_b': nrm((DEPTH, D_MODEL), 0.02),
    }


def reference(x_prompt, x_sample, cache_fox_k, cache_fox_v, cache_fox_logf, state_rwkv_wkv, state_rwkv_shift,
              w_in, rwkv_mu, rwkv_w0, rwkv_w2, rwkv_a0, rwkv_a2, rwkv_g2, rwkv_k_k, rwkv_k_a, rwkv_r_k,
              rwkv_lnx_g, rwkv_lnx_b, fox_b_f, fox_out_g, w_o, ln1_g, ln1_b, w_up, w_down, ln2_g, ln2_b):
    assert x_sample.shape[1] <= CHUNK
    xp, xs = x_prompt, x_sample
    bp = xp.shape[0]
    pk, pv, pf, pS, psh = [], [], [], [], []
    sk, sv, sf, sS, ssh = [], [], [], [], []
    for l in range(DEPTH):
        lw = (w_in[l], rwkv_mu[l], rwkv_w0[l], rwkv_w2[l], rwkv_a0[l], rwkv_a2[l], rwkv_g2[l],
              rwkv_k_k[l], rwkv_k_a[l], rwkv_r_k[l], rwkv_lnx_g[l], rwkv_lnx_b[l], fox_b_f[l], fox_out_g[l],
              w_o[l], ln1_g[l], ln1_b[l], w_up[l], w_down[l], ln2_g[l], ln2_b[l])
        shift0 = jnp.zeros((bp, 1, RWKV_PROJ), xp.dtype)
        s_zero = jnp.zeros((bp, RWKV_HEADS, HEAD_DIM, HEAD_DIM), jnp.float32)
        xp, k_p, v_p, f_p, S_p, sh_p = hybrid_layer(xp, shift0, s_zero, fox_prompt_attention, *lw)
        fox_s = functools.partial(fox_sample_attention, cache_k=cache_fox_k[l], cache_v=cache_fox_v[l],
                                  cache_logf=cache_fox_logf[l])
        xs, k_s, v_s, f_s, S_s, sh_s = hybrid_layer(xs, state_rwkv_shift[l], state_rwkv_wkv[l], fox_s, *lw)
        pk.append(k_p); pv.append(v_p); pf.append(f_p); pS.append(S_p); psh.append(sh_p)
        sk.append(k_s); sv.append(v_s); sf.append(f_s); sS.append(S_s); ssh.append(sh_s)
    return (xp, xs,
            jnp.stack(pk), jnp.stack(pv), jnp.stack(pf), jnp.stack(pS), jnp.stack(psh),
            jnp.stack(sk), jnp.stack(sv), jnp.stack(sf), jnp.stack(sS), jnp.stack(ssh))
```

```cpp
#include <hip/hip_runtime.h>
#include <hip/hip_cooperative_groups.h>
#include <cstdio>
#include <cstdint>
namespace pg8 {
#define PG8_LAS __attribute__((address_space(3)))
typedef unsigned short bf16_t;
typedef short bf16x8 __attribute__((ext_vector_type(8)));
typedef float f32x4 __attribute__((ext_vector_type(4)));
typedef unsigned u32x4 __attribute__((ext_vector_type(4)));
constexpr int BM = 256, BK = 64, HALF = 128, HTB = HALF * BK * 2  , STAGE_BYTES = 8 * HTB, NXCD = 8, WGM = 8;

__host__ __device__ __forceinline__ int lds_byte(int r, int c) { const int st = (r >> 4) * 2 + (c >> 5), rr = r & 15, cc = c & 31, ob = rr * 64 + cc * 2; return st * 1024 + (ob ^ (((ob >> 9) & 1) << 5)); }
__host__ __device__ __forceinline__ void stage_rc(int b, int& R, int& C) { const int st = b / 1024, sb = b % 1024, swz = sb ^ (((sb >> 9) & 1) << 5); R = (st >> 1) * 16 + swz / 64; C = (st & 1) * 32 + (swz % 64) / 2; }
__host__ __device__ __forceinline__ int perm32(int rho) { const int n = rho >> 4, i = rho & 15; return 8 * (i >> 2) + 4 * n + (i & 3); }

struct Unit { int pm, pn, k0, nt, smp; };
struct Gemm { const bf16_t* A; const bf16_t* Bt; int M, N, K; };

struct StaticOrder {
    int nM, nN, nwg, G, c, ntk;
    __host__ __device__ void init(int M, int N, int K, int G_, int c_) { nM = M / BM; nN = N / BM; nwg = nM * nN; G = G_; c = c_; ntk = K / BK; }
    __host__ __device__ bool next(int i, Unit& u) const {
        const long L = (long)i * G + c; if (L >= nwg) return false;
        int wgid = (int)L; { const int q = nwg / NXCD, r = nwg % NXCD, xcd = wgid % NXCD, off = wgid / NXCD; wgid = (xcd < r ? xcd * (q + 1) : r * (q + 1) + (xcd - r) * q) + off; }
        const int nig = WGM * nN, gid = wgid / nig, fm = gid * WGM, gsz = (nM - fm) < WGM ? (nM - fm) : WGM;
        u.pm = fm + ((wgid % nig) % gsz); u.pn = (wgid % nig) / gsz; u.k0 = 0; u.nt = ntk; u.smp = 0; return true;
    }
    __device__ __forceinline__ void a_ready(const Unit&) const {}
    __device__ __forceinline__ void done(const Unit&) const {}
};

struct SplitOrder {
    StaticOrder P; int nN, nks, KC;
    __host__ __device__ void init(int N, int K, int G_, int c_, int KC_) { P.init(8192, N, K, G_, c_); nN = N / BM; KC = KC_; nks = K / KC_; }
    __host__ __device__ bool next(int i, Unit& u) const {
        const long L = (long)i * P.G + P.c;
        if (L < P.nwg) return P.next(i, u);
        const int idx = (int)(L - P.nwg); if (idx >= nN * nks) return false;
        u.pm = 32; u.pn = idx % nN; u.k0 = (idx / nN) * KC; u.nt = KC / BK; u.smp = 1; return true;
    }
    __device__ __forceinline__ void a_ready(const Unit&) const {}
    __device__ __forceinline__ void done(const Unit&) const {}
};

__device__ __forceinline__ unsigned cvt_pk_bf16(float lo, float hi) { unsigned r; asm volatile("v_cvt_pk_bf16_f32 %0, %1, %2" : "=v"(r) : "v"(lo), "v"(hi)); return r; }
template <class Epi, class Sched, bool ALIGN_EPI = false, bool SP2 = false>
__device__ __forceinline__ void gemm_phase(PG8_LAS unsigned char* lds, const Gemm g, const Sched& S, const Epi& E) {
    const int tid = threadIdx.x, wid = __builtin_amdgcn_readfirstlane(tid >> 6), lane = tid & 63, wr = wid >> 2, wc = wid & 3, fr = lane & 15, fq = lane >> 4;
    const int K = g.K;
    unsigned voffA[2], voffB[2];
#pragma unroll
    for (int i = 0; i < 2; ++i) { int R, C; stage_rc(tid * 16 + i * 8192, R, C); const int Rb = Epi::PERM ? ((R & ~31) + perm32(R & 31)) : R;
        voffA[i] = (unsigned)(R * K + C) * 2u; voffB[i] = (unsigned)(Rb * K + C) * 2u; }
    const size_t kstep = (size_t)(BK * 2);
    const size_t hstep = (size_t)HALF * K * 2;
    const size_t tstep = 2 * hstep;
    const unsigned ldsw = (unsigned)wid * 1024u;
    const int aoff = lds_byte(wr * 64 + fr, fq * 8), boff = lds_byte(wc * 32 + fr, fq * 8);
#define PG8_SA(b, h) (((b) * 2 + (h)) * HTB)
#define PG8_SB(b, h) ((4 + (b) * 2 + (h)) * HTB)
#define PG8_STAGE(bufoff, gbase, voff) do { _Pragma("unroll") for (int _i = 0; _i < 2; ++_i) \
        __builtin_amdgcn_global_load_lds((const unsigned*)((const char*)(gbase) + (voff)[_i]), (PG8_LAS unsigned*)(lds + (bufoff) + ldsw + _i * 8192), 16, 0, 0); } while (0)
#define PG8_LDA(dst, b, h) do { _Pragma("unroll") for (int m = 0; m < 4; ++m) _Pragma("unroll") for (int k = 0; k < 2; ++k) dst[m][k] = *(const PG8_LAS bf16x8*)(lds + PG8_SA(b, h) + aoff + m * 2048 + k * 1024); } while (0)
#define PG8_LDB(dst, b, h) do { _Pragma("unroll") for (int n = 0; n < 2; ++n) _Pragma("unroll") for (int k = 0; k < 2; ++k) dst[n][k] = *(const PG8_LAS bf16x8*)(lds + PG8_SB(b, h) + boff + n * 2048 + k * 1024); } while (0)
#define PG8_MMA(ai, bj, At, Bt) do { __builtin_amdgcn_s_setprio(1); _Pragma("unroll") for (int m = 0; m < 4; ++m) _Pragma("unroll") for (int n = 0; n < 2; ++n) _Pragma("unroll") for (int k = 0; k < 2; ++k) \
        acc[ai][bj][m][n] = __builtin_amdgcn_mfma_f32_16x16x32_bf16(Bt[n][k], At[m][k], acc[ai][bj][m][n], 0, 0, 0); __builtin_amdgcn_s_setprio(0); } while (0)
#define PG8_WAIT_V(n) asm volatile("s_waitcnt vmcnt(" #n ")" ::: "memory")
#define PG8_WAIT_L(n) asm volatile("s_waitcnt lgkmcnt(" #n ")" ::: "memory")
#define PG8_BAR __builtin_amdgcn_s_barrier()
#define PG8_SCHED __builtin_amdgcn_sched_barrier(0)
    Unit cur, nxt; int ui = 0;
    if (!S.next(0, cur)) return;
    f32x4 acc[2][2][4][2];
#pragma unroll
    for (int a = 0; a < 2; ++a)
#pragma unroll
        for (int b = 0; b < 2; ++b)
#pragma unroll
            for (int m = 0; m < 4; ++m)
#pragma unroll
                for (int n = 0; n < 2; ++n) acc[a][b][m][n] = (f32x4){0.f, 0.f, 0.f, 0.f};
    bf16x8 At[4][2], B0[2][2], B1[2][2];
    const char* cA = (const char*)g.A + (size_t)cur.pm * tstep + (size_t)cur.k0 * 2; const char* cB = (const char*)g.Bt + (size_t)cur.pn * tstep + (size_t)cur.k0 * 2;
    S.a_ready(cur);
    if constexpr (SP2) {
        PG8_STAGE(PG8_SB(0, 0), cB, voffB); PG8_STAGE(PG8_SB(0, 1), cB + hstep, voffB); PG8_STAGE(PG8_SA(0, 0), cA, voffA); PG8_STAGE(PG8_SA(0, 1), cA + hstep, voffA);
        if (wr == 1) PG8_BAR;
        PG8_WAIT_V(2); PG8_BAR;
        PG8_STAGE(PG8_SB(1, 0), cB + kstep, voffB); PG8_STAGE(PG8_SA(1, 0), cA + kstep, voffA); PG8_STAGE(PG8_SB(1, 1), cB + hstep + kstep, voffB);
        PG8_WAIT_V(6); PG8_BAR;
    } else {
        PG8_STAGE(PG8_SB(0, 0), cB, voffB); PG8_STAGE(PG8_SA(0, 0), cA, voffA); PG8_STAGE(PG8_SB(0, 1), cB + hstep, voffB); PG8_STAGE(PG8_SA(0, 1), cA + hstep, voffA);
        if (wr == 1) PG8_BAR;
        PG8_WAIT_V(4); PG8_BAR;
        PG8_STAGE(PG8_SB(1, 0), cB + kstep, voffB); PG8_STAGE(PG8_SA(1, 0), cA + kstep, voffA); PG8_STAGE(PG8_SB(1, 1), cB + hstep + kstep, voffB);
        PG8_WAIT_V(6); PG8_BAR;
    }
    for (;;) {
        const bool has_next = S.next(ui + 1, nxt);
        const char* nA = has_next ? (const char*)g.A + (size_t)nxt.pm * tstep + (size_t)nxt.k0 * 2 : cA; const char* nB = has_next ? (const char*)g.Bt + (size_t)nxt.pn * tstep + (size_t)nxt.k0 * 2 : cB;
        const int nt = cur.nt;
        for (int t = 0; t < nt; t += 2) {
            const bool last = (t == nt - 2);
            const char* a1 = cA + (size_t)(t + 1) * kstep;
            const char* a2 = last ? nA : cA + (size_t)(t + 2) * kstep; const char* b2 = last ? nB : cB + (size_t)(t + 2) * kstep;
            const char* a3 = a2 + kstep; const char* b3 = b2 + kstep;
            if (last && has_next) S.a_ready(nxt);
            if constexpr (SP2) {
            PG8_LDB(B0, 0, 0); PG8_LDB(B1, 0, 1); PG8_SCHED; PG8_LDA(At, 0, 0); PG8_STAGE(PG8_SA(1, 1), a1 + hstep, voffA);
            PG8_WAIT_V(8); PG8_WAIT_L(0); PG8_BAR; PG8_MMA(0, 0, At, B0); PG8_MMA(0, 1, At, B1); PG8_BAR; PG8_SCHED;
            PG8_LDA(At, 0, 1); PG8_STAGE(PG8_SB(0, 0), b2, voffB); PG8_STAGE(PG8_SB(0, 1), b2 + hstep, voffB); PG8_STAGE(PG8_SA(0, 0), a2, voffA);
            PG8_WAIT_V(8); PG8_WAIT_L(0); PG8_BAR; PG8_MMA(1, 0, At, B0); PG8_MMA(1, 1, At, B1); PG8_BAR; PG8_SCHED;
            PG8_LDB(B0, 1, 0); PG8_LDB(B1, 1, 1); PG8_SCHED; PG8_LDA(At, 1, 0); PG8_STAGE(PG8_SA(0, 1), a2 + hstep, voffA);
            PG8_WAIT_V(8); PG8_WAIT_L(0); PG8_BAR; PG8_MMA(0, 0, At, B0); PG8_MMA(0, 1, At, B1); PG8_BAR; PG8_SCHED;
            PG8_LDA(At, 1, 1); PG8_STAGE(PG8_SB(1, 0), b3, voffB); PG8_STAGE(PG8_SB(1, 1), b3 + hstep, voffB); PG8_STAGE(PG8_SA(1, 0), a3, voffA);
            PG8_WAIT_V(8); PG8_WAIT_L(0); PG8_BAR; PG8_MMA(1, 0, At, B0); PG8_MMA(1, 1, At, B1); PG8_BAR; PG8_SCHED;
            } else {
            PG8_LDB(B0, 0, 0); PG8_SCHED; PG8_LDA(At, 0, 0); PG8_STAGE(PG8_SA(1, 1), a1 + hstep, voffA);
            PG8_WAIT_L(8); PG8_BAR; PG8_WAIT_L(0); PG8_MMA(0, 0, At, B0); PG8_BAR; PG8_SCHED;
            PG8_LDB(B1, 0, 1); PG8_STAGE(PG8_SB(0, 0), b2, voffB);
            PG8_BAR; PG8_WAIT_L(0); PG8_MMA(0, 1, At, B1); PG8_BAR;
            PG8_LDA(At, 0, 1); PG8_STAGE(PG8_SA(0, 0), a2, voffA);
            PG8_BAR; PG8_WAIT_L(0); PG8_MMA(1, 0, At, B0); PG8_BAR; PG8_SCHED;
            PG8_STAGE(PG8_SB(0, 1), b2 + hstep, voffB);
            PG8_WAIT_V(6); PG8_BAR; PG8_MMA(1, 1, At, B1); PG8_BAR;
            PG8_LDB(B0, 1, 0); PG8_SCHED; PG8_LDA(At, 1, 0); PG8_STAGE(PG8_SA(0, 1), a2 + hstep, voffA);
            PG8_WAIT_L(8); PG8_BAR; PG8_WAIT_L(0); PG8_MMA(0, 0, At, B0); PG8_BAR; PG8_SCHED;
            PG8_LDB(B1, 1, 1); PG8_STAGE(PG8_SB(1, 0), b3, voffB);
            PG8_BAR; PG8_WAIT_L(0); PG8_MMA(0, 1, At, B1); PG8_BAR;
            PG8_LDA(At, 1, 1); PG8_STAGE(PG8_SA(1, 0), a3, voffA);
            PG8_BAR; PG8_WAIT_L(0); PG8_MMA(1, 0, At, B0); PG8_BAR; PG8_SCHED;
            PG8_STAGE(PG8_SB(1, 1), b3 + hstep, voffB);
            PG8_WAIT_V(6); PG8_BAR; PG8_MMA(1, 1, At, B1); PG8_BAR;
            }
        }
        if constexpr (ALIGN_EPI) { if (wr == 0) PG8_BAR; }
        if constexpr (!Epi::AFTER_DRAIN) { E(acc, cur, wr, wc, fr, fq); S.done(cur); }
        if (!has_next) break;
#pragma unroll
        for (int a = 0; a < 2; ++a)
#pragma unroll
            for (int b = 0; b < 2; ++b)
#pragma unroll
                for (int m = 0; m < 4; ++m)
#pragma unroll
                    for (int n = 0; n < 2; ++n) acc[a][b][m][n] = (f32x4){0.f, 0.f, 0.f, 0.f};
        cur = nxt; cA = nA; cB = nB; ++ui;
        if constexpr (ALIGN_EPI) { if (wr == 1) PG8_BAR; }
    }
    PG8_WAIT_V(0);
    if constexpr (!ALIGN_EPI) { if (wr == 0) PG8_BAR; }
    PG8_BAR;
    if constexpr (Epi::AFTER_DRAIN) { E.fused(acc, cur, wr, wc, fr, fq, lds, wid, lane); S.done(cur); }
#undef PG8_SA
#undef PG8_SB
#undef PG8_STAGE
#undef PG8_LDA
#undef PG8_LDB
#undef PG8_MMA
#undef PG8_WAIT_V
#undef PG8_WAIT_L
#undef PG8_BAR
#undef PG8_SCHED
}
}

#ifndef ONE_LAUNCH
#define ONE_LAUNCH 1
#endif
namespace cg = cooperative_groups;
namespace pg8 {
#define LAS __attribute__((address_space(3)))
typedef float f32x16 __attribute__((ext_vector_type(16)));
typedef unsigned u32x2 __attribute__((ext_vector_type(2)));
constexpr int DM = 2048, TP = 4096, MP = 8192, MR = 8320, MT = 8448;
constexpr int RPROJ = 3360, PTOT = 7472, NIN = 7680, DFF = 8192;
constexpr int C_Q = 3360, C_K = 4384, C_V = 5408, C_F = 6432, C_OG = 6448;
constexpr int KL = 384, NL = 3072;
constexpr float ALPHA_RES = 1.189207115002721f;
constexpr float LOG2E = 1.4426950408889634f;
constexpr float QSCALE = 0.125f * 1.4426950408889634f;
constexpr size_t OFF_YS = 16777216, OFF_PK = 17039360, OFF_PV = 25427968, OFF_PLOGF = 33816576, OFF_PWKV = 33947648, OFF_PSHIFT = 34078720,
                 OFF_SK = 34085440, OFF_SV = 34216512, OFF_SLOGF = 34347584, OFF_SWKV = 34349632, OFF_SSHIFT = 34873920, OUT_TOTAL = 34900800;
constexpr size_t MiB = 1u << 20;
constexpr size_t WS_CTL = 0, WS_WIN = 1 * MiB, WS_LIN = 1 * MiB, WS_G = 8 * MiB, WS_KE = 25 * MiB, WS_WO = 31 * MiB, WS_WUP = 39 * MiB, WS_WDN = 71 * MiB, WS_LORA = 103 * MiB,
                 WS_XB = 106 * MiB, WS_YMIX = 106 * MiB, WS_PR = 139 * MiB, WS_HB = 139 * MiB, WS_Q = 194 * MiB, WS_KB = 210 * MiB + MiB / 2, WS_VT = 227 * MiB, WS_OG = 243 * MiB + MiB / 2,
                 WS_SLAB1 = 1 * MiB, WS_SLAB2 = 8 * MiB, WS_W = 260 * MiB, WS_ALR = 293 * MiB, WS_U = 172 * MiB, WS_END = 310 * MiB;
constexpr int LDS_BYTES = 147456, LDS_WORD_OFF = 140032, LDS_BARW_OFF = 140096, CW_BAR = 4096;
constexpr int NPH = 11;

struct Args { const float* in[28]; float* out; unsigned char* ws; int ph_lo, ph_hi, rep, pad; };

__device__ __forceinline__ unsigned f2bf(float f) { unsigned u = __builtin_bit_cast(unsigned, f); return (u + 0x7fffu + ((u >> 16) & 1u)) >> 16; }
__device__ __forceinline__ float bf2f(unsigned h) { return __builtin_bit_cast(float, h << 16); }
__device__ __forceinline__ float bflo(unsigned p) { return __builtin_bit_cast(float, p << 16); }
__device__ __forceinline__ float bfhi(unsigned p) { return __builtin_bit_cast(float, p & 0xffff0000u); }
__device__ __forceinline__ unsigned pk2(float lo, float hi) { return f2bf(lo) | (f2bf(hi) << 16); }
__device__ __forceinline__ float sigmoidf_(float x) { return 1.0f / (1.0f + __expf(-x)); }
#define LDS_WAIT() asm volatile("s_waitcnt lgkmcnt(0)" ::: "memory")

struct EpiIn {
    static constexpr bool PERM = true, AFTER_DRAIN = false;
    bf16_t *PR, *Q, *KB, *VT, *OG; float* out; const float* b_f;
    __device__ __forceinline__ void one(const f32x4 v0, const f32x4 v1, const int row, const int c0) const {
        if (c0 < C_Q) {
            u32x4 w; w.x = cvt_pk_bf16(v0[0], v0[1]); w.y = cvt_pk_bf16(v0[2], v0[3]); w.z = cvt_pk_bf16(v1[0], v1[1]); w.w = cvt_pk_bf16(v1[2], v1[3]);
            *(u32x4*)(PR + (size_t)row * RPROJ + c0) = w;
            if (row < MP) { if ((row & (TP - 1)) == TP - 1) { float* o = out + OFF_PSHIFT + (size_t)(row >> 12) * RPROJ + c0; *(f32x4*)o = v0; *(f32x4*)(o + 4) = v1; } }
            else { const int sr = row - MP; if ((sr & 15) == 15) { float* o = out + OFF_SSHIFT + (size_t)(sr >> 4) * RPROJ + c0; *(f32x4*)o = v0; *(f32x4*)(o + 4) = v1; } }
        } else if (c0 < C_K) {
            const f32x4 a = v0 * QSCALE, b = v1 * QSCALE;
            u32x4 w; w.x = cvt_pk_bf16(a[0], a[1]); w.y = cvt_pk_bf16(a[2], a[3]); w.z = cvt_pk_bf16(b[0], b[1]); w.w = cvt_pk_bf16(b[2], b[3]);
            *(u32x4*)(Q + (size_t)row * 1024 + (c0 - C_Q)) = w;
        } else if (c0 < C_V) {
            const int col = c0 - C_K;
            float* o = (row < MP) ? out + OFF_PK + (size_t)row * 1024 + col : out + OFF_SK + (size_t)(row - MP) * 1024 + col;
            *(f32x4*)o = v0; *(f32x4*)(o + 4) = v1;
            if (row < MP) { u32x4 w; w.x = cvt_pk_bf16(v0[0], v0[1]); w.y = cvt_pk_bf16(v0[2], v0[3]); w.z = cvt_pk_bf16(v1[0], v1[1]); w.w = cvt_pk_bf16(v1[2], v1[3]);
                *(u32x4*)(KB + (size_t)row * 1024 + col) = w; }
        } else if (c0 < C_F) {
            const int col = c0 - C_V;
            float* o = (row < MP) ? out + OFF_PV + (size_t)row * 1024 + col : out + OFF_SV + (size_t)(row - MP) * 1024 + col;
            *(f32x4*)o = v0; *(f32x4*)(o + 4) = v1;
            if (row < MP) {
                const int bb = row >> 12, t = row & (TP - 1), hh = col >> 6, d0 = col & 63;
                bf16_t* vt = VT + ((size_t)(bb * 16 + hh) * 64 + d0) * TP + t;
                const unsigned p0 = cvt_pk_bf16(v0[0], v0[1]), p1 = cvt_pk_bf16(v0[2], v0[3]), p2 = cvt_pk_bf16(v1[0], v1[1]), p3 = cvt_pk_bf16(v1[2], v1[3]);
                vt[0] = (bf16_t)(p0 & 0xffffu); vt[(size_t)1 * TP] = (bf16_t)(p0 >> 16); vt[(size_t)2 * TP] = (bf16_t)(p1 & 0xffffu); vt[(size_t)3 * TP] = (bf16_t)(p1 >> 16);
                vt[(size_t)4 * TP] = (bf16_t)(p2 & 0xffffu); vt[(size_t)5 * TP] = (bf16_t)(p2 >> 16); vt[(size_t)6 * TP] = (bf16_t)(p3 & 0xffffu); vt[(size_t)7 * TP] = (bf16_t)(p3 >> 16);
            }
        } else if (c0 < C_OG) {
            const int h0 = c0 - C_F;
            float* o = (row < MP) ? out + OFF_PLOGF + (size_t)row * 16 + h0 : out + OFF_SLOGF + (size_t)(row - MP) * 16 + h0;
            f32x4 r0, r1;
#pragma unroll
            for (int j = 0; j < 4; ++j) {
                const float x0 = v0[j] + b_f[h0 + j], x1 = v1[j] + b_f[h0 + 4 + j];
                r0[j] = fminf(x0, 0.f) - __logf(1.0f + __expf(-fabsf(x0))); r1[j] = fminf(x1, 0.f) - __logf(1.0f + __expf(-fabsf(x1)));
            }
            *(f32x4*)o = r0; *(f32x4*)(o + 4) = r1;
        } else if (c0 < PTOT) {
            f32x4 a, b;
#pragma unroll
            for (int j = 0; j < 4; ++j) { a[j] = sigmoidf_(v0[j]); b[j] = sigmoidf_(v1[j]); }
            u32x4 w; w.x = cvt_pk_bf16(a[0], a[1]); w.y = cvt_pk_bf16(a[2], a[3]); w.z = cvt_pk_bf16(b[0], b[1]); w.w = cvt_pk_bf16(b[2], b[3]);
            *(u32x4*)(OG + (size_t)row * 1024 + (c0 - C_OG)) = w;
        }
    }
    template <int I> __device__ __forceinline__ void rows(const f32x4 (&acc)[2][2][4][2], const int row0, const int cb) const {
        constexpr int ai = I >> 2, m = I & 3;
        const int row = row0 + ai * HALF + m * 16;
        if (row < MR) { one(acc[ai][0][m][0], acc[ai][0][m][1], row, cb); one(acc[ai][1][m][0], acc[ai][1][m][1], row, cb + HALF); }
    }
    __device__ __forceinline__ void operator()(const f32x4 (&acc)[2][2][4][2], const Unit& u, int wr, int wc, int fr, int fq) const {
        const int row0 = u.pm * BM + wr * 64 + fr;
        const int cb = u.pn * BM + wc * 32 + 8 * fq;
        rows<0>(acc, row0, cb); rows<1>(acc, row0, cb); rows<2>(acc, row0, cb); rows<3>(acc, row0, cb);
        rows<4>(acc, row0, cb); rows<5>(acc, row0, cb); rows<6>(acc, row0, cb); rows<7>(acc, row0, cb);
    }
};

struct EpiLora {
    static constexpr bool PERM = true, AFTER_DRAIN = false;
    float* W; bf16_t *ALR, *G; const float *w0, *a0;
    template <int REG> __device__ __forceinline__ void one(const f32x4 x0, const f32x4 x1, const int row, const int c0) const {
        if (REG == 0) {
            const f32x4 v0 = x0 + *(const f32x4*)(w0 + c0), v1 = x1 + *(const f32x4*)(w0 + c0 + 4);
            f32x4 r0, r1;
#pragma unroll
            for (int j = 0; j < 4; ++j) {
                const float p0 = v0[j], p1 = v1[j];
                const float l0 = fminf(p0, 0.f) - __logf(1.0f + __expf(-fabsf(p0))) - 0.5f, l1 = fminf(p1, 0.f) - __logf(1.0f + __expf(-fabsf(p1))) - 0.5f;
                r0[j] = __expf(-__expf(l0)); r1[j] = __expf(-__expf(l1));
            }
            float* o = W + (size_t)row * 1024 + c0; *(f32x4*)o = r0; *(f32x4*)(o + 4) = r1;
        } else if (REG == 1) {
            const f32x4 v0 = x0 + *(const f32x4*)(a0 + c0 - 1024), v1 = x1 + *(const f32x4*)(a0 + c0 - 1020);
            f32x4 a, b;
#pragma unroll
            for (int j = 0; j < 4; ++j) { a[j] = sigmoidf_(v0[j]); b[j] = sigmoidf_(v1[j]); }
            u32x4 w; w.x = cvt_pk_bf16(a[0], a[1]); w.y = cvt_pk_bf16(a[2], a[3]); w.z = cvt_pk_bf16(b[0], b[1]); w.w = cvt_pk_bf16(b[2], b[3]);
            *(u32x4*)(ALR + (size_t)row * 1024 + (c0 - 1024)) = w;
        } else {
            u32x4 w; w.x = cvt_pk_bf16(x0[0], x0[1]); w.y = cvt_pk_bf16(x0[2], x0[3]); w.z = cvt_pk_bf16(x1[0], x1[1]); w.w = cvt_pk_bf16(x1[2], x1[3]);
            *(u32x4*)(G + (size_t)row * 1024 + (c0 - 2048)) = w;
        }
    }
    template <int I, int REG> __device__ __forceinline__ void rows(const f32x4 (&acc)[2][2][4][2], const int row0, const int cb) const {
        constexpr int ai = I >> 2, m = I & 3;
        const int row = row0 + ai * HALF + m * 16;
        if (row < MR) { one<REG>(acc[ai][0][m][0], acc[ai][0][m][1], row, cb); one<REG>(acc[ai][1][m][0], acc[ai][1][m][1], row, cb + HALF); }
    }
    template <int REG> __device__ __forceinline__ void all(const f32x4 (&acc)[2][2][4][2], const int row0, const int cb) const {
        rows<0, REG>(acc, row0, cb); rows<1, REG>(acc, row0, cb); rows<2, REG>(acc, row0, cb); rows<3, REG>(acc, row0, cb);
        rows<4, REG>(acc, row0, cb); rows<5, REG>(acc, row0, cb); rows<6, REG>(acc, row0, cb); rows<7, REG>(acc, row0, cb);
    }
    __device__ __forceinline__ void operator()(const f32x4 (&acc)[2][2][4][2], const Unit& u, int wr, int wc, int fr, int fq) const {
        const int row0 = u.pm * BM + wr * 64 + fr;
        const int cb = u.pn * BM + wc * 32 + 8 * fq;
        const int reg = __builtin_amdgcn_readfirstlane(u.pn >> 2);
        if (reg == 0) all<0>(acc, row0, cb); else if (reg == 1) all<1>(acc, row0, cb); else all<2>(acc, row0, cb);
    }
};

struct EpiRes {
    static constexpr bool PERM = true, AFTER_DRAIN = false;
    const float* basep; float* Z; float* slab; int KC;
    __device__ __forceinline__ void operator()(const f32x4 (&acc)[2][2][4][2], const Unit& u, int wr, int wc, int fr, int fq) const {
        if (u.smp) {
            float* sp = slab + (size_t)(u.k0 / KC) * (128 * DM) + (size_t)(wr * 64 + fr) * DM + u.pn * BM + wc * 32 + 8 * fq;
#pragma unroll
            for (int m = 0; m < 4; ++m)
#pragma unroll
                for (int bj = 0; bj < 2; ++bj) { *(f32x4*)(sp + (size_t)m * 16 * DM + bj * HALF) = acc[0][bj][m][0]; *(f32x4*)(sp + (size_t)m * 16 * DM + bj * HALF + 4) = acc[0][bj][m][1]; }
            return;
        }
        const int row0 = u.pm * BM + wr * 64 + fr;
#pragma unroll
        for (int ai = 0; ai < 2; ++ai)
#pragma unroll
            for (int m = 0; m < 4; ++m) {
                const int row = row0 + ai * HALF + m * 16;
                const float* bp = basep + (size_t)row * DM;
                float* zp = Z + (size_t)row * DM;
#pragma unroll
                for (int bj = 0; bj < 2; ++bj) {
                    const int c0 = u.pn * BM + bj * HALF + wc * 32 + 8 * fq;
                    const f32x4 x0 = *(const f32x4*)(bp + c0), x1 = *(const f32x4*)(bp + c0 + 4);
                    *(f32x4*)(zp + c0) = x0 * ALPHA_RES + acc[ai][bj][m][0]; *(f32x4*)(zp + c0 + 4) = x1 * ALPHA_RES + acc[ai][bj][m][1];
                }
            }
    }
};

struct EpiUp {
    static constexpr bool PERM = true, AFTER_DRAIN = false;
    bf16_t* U;
    __device__ __forceinline__ void operator()(const f32x4 (&acc)[2][2][4][2], const Unit& u, int wr, int wc, int fr, int fq) const {
        const int row0 = u.pm * BM + wr * 64 + fr;
#pragma unroll
        for (int ai = 0; ai < 2; ++ai)
#pragma unroll
            for (int m = 0; m < 4; ++m) {
                bf16_t* rowp = U + (size_t)(row0 + ai * HALF + m * 16) * DFF + u.pn * BM + wc * 32 + 8 * fq;
#pragma unroll
                for (int bj = 0; bj < 2; ++bj) {
                    f32x4 v0 = acc[ai][bj][m][0], v1 = acc[ai][bj][m][1];
#pragma unroll
                    for (int j = 0; j < 4; ++j) { const float a = fmaxf(v0[j], 0.f), b = fmaxf(v1[j], 0.f); v0[j] = a * a; v1[j] = b * b; }
                    u32x4 w; w.x = cvt_pk_bf16(v0[0], v0[1]); w.y = cvt_pk_bf16(v0[2], v0[3]); w.z = cvt_pk_bf16(v1[0], v1[1]); w.w = cvt_pk_bf16(v1[2], v1[3]);
                    *(u32x4*)(rowp + bj * HALF) = w;
                }
            }
    }
};

__device__ __forceinline__ float wave_sum(float v) {
#pragma unroll
    for (int o = 1; o < 64; o <<= 1) v += __shfl_xor(v, o);
    return v;
}
__device__ __forceinline__ float wave_max(float v) {
#pragma unroll
    for (int o = 1; o < 64; o <<= 1) v = fmaxf(v, __shfl_xor(v, o));
    return v;
}
__device__ __forceinline__ float red32(float v) {
#pragma unroll
    for (int o = 1; o < 32; o <<= 1) v += __shfl_xor(v, o);
    return v;
}
template <int CTRL> __device__ __forceinline__ float dpp_add(float x) {
    return x + __builtin_bit_cast(float, __builtin_amdgcn_update_dpp(0, __builtin_bit_cast(int, x), CTRL, 0xf, 0xf, false));
}
__device__ __forceinline__ float row16_sum(float x) {
    x = dpp_add<0xB1>(x); x = dpp_add<0x4E>(x); x = dpp_add<0x141>(x); x = dpp_add<0x140>(x); return x;
}

__device__ __forceinline__ void p0_transpose_item(const float* __restrict__ W, int K, int N, bf16_t* __restrict__ WT, LAS float* scr, int item, int lane) {
    const int nblk = (N + 31) >> 5, kb = item / nblk, nb = item - kb * nblk, k0 = 64 * kb, n0 = 32 * nb;
    const int kr = lane >> 3, n4 = (lane & 7) * 4; const bool ok = (n0 + n4) < N;
    f32x4 v[8];
#pragma unroll
    for (int i = 0; i < 8; ++i) v[i] = ok ? *(const f32x4*)(W + (size_t)(k0 + kr + 8 * i) * N + n0 + n4) : (f32x4){0.f, 0.f, 0.f, 0.f};
#pragma unroll
    for (int i = 0; i < 8; ++i) { LAS float* d = scr + (kr + 8 * i) * 33 + n4; d[0] = v[i][0]; d[1] = v[i][1]; d[2] = v[i][2]; d[3] = v[i][3]; }
    LDS_WAIT();
    const int c = lane & 7;
#pragma unroll
    for (int j = 0; j < 4; ++j) { const int n = (lane >> 3) + 8 * j; const LAS float* s = scr + (8 * c) * 33 + n;
        u32x4 o; o.x = pk2(s[0 * 33], s[1 * 33]); o.y = pk2(s[2 * 33], s[3 * 33]); o.z = pk2(s[4 * 33], s[5 * 33]); o.w = pk2(s[6 * 33], s[7 * 33]);
        *(u32x4*)(WT + (size_t)(n0 + n) * K + k0 + 8 * c) = o; }
    LDS_WAIT();
}
constexpr int I_IN = (DM / 64) * ((PTOT + 31) / 32), I_O = (DM / 64) * (DM / 32), I_UP = (DM / 64) * (DFF / 32), I_DN = (DFF / 64) * (DM / 32);
__device__ __forceinline__ void late_transpose_item(const Args& a, LAS float* scr, int r, int lane) {
    unsigned char* ws = a.ws;
    if (r < I_O) { p0_transpose_item(a.in[21], DM, DM, (bf16_t*)(ws + WS_WO), scr, r, lane); return; } r -= I_O;
    if (r < I_UP) { p0_transpose_item(a.in[24], DM, DFF, (bf16_t*)(ws + WS_WUP), scr, r, lane); return; } r -= I_UP;
    if (r < I_DN) p0_transpose_item(a.in[25], DFF, DM, (bf16_t*)(ws + WS_WDN), scr, r, lane);
}

__device__ __forceinline__ void late_item_desc(const Args& a, int r, const float*& W, bf16_t*& WT, int& K, int& N, int& ri) {
    unsigned char* ws = a.ws;
    if (r < I_O) { W = a.in[21]; WT = (bf16_t*)(ws + WS_WO); K = DM; N = DM; ri = r; }
    else if (r < I_O + I_UP) { W = a.in[24]; WT = (bf16_t*)(ws + WS_WUP); K = DM; N = DFF; ri = r - I_O; }
    else { W = a.in[25]; WT = (bf16_t*)(ws + WS_WDN); K = DFF; N = DM; ri = r - I_O - I_UP; }
}
__device__ __forceinline__ void late_item_load(const Args& a, int r, int lane, f32x4 (&v)[8]) {
    const float* W; bf16_t* WT; int K, N, ri; late_item_desc(a, r, W, WT, K, N, ri);
    const int nblk = N >> 5, kb = ri / nblk, nb = ri - kb * nblk, k0 = 64 * kb, n0 = 32 * nb, kr = lane >> 3, n4 = (lane & 7) * 4;
#pragma unroll
    for (int i = 0; i < 8; ++i) v[i] = *(const f32x4*)(W + (size_t)(k0 + kr + 8 * i) * N + n0 + n4);
}
__device__ __forceinline__ void late_item_finish(const Args& a, int r, int lane, const f32x4 (&v)[8], LAS float* scr) {
    const float* W; bf16_t* WT; int K, N, ri; late_item_desc(a, r, W, WT, K, N, ri);
    const int nblk = N >> 5, kb = ri / nblk, nb = ri - kb * nblk, k0 = 64 * kb, n0 = 32 * nb, kr = lane >> 3, n4 = (lane & 7) * 4;
#pragma unroll
    for (int i = 0; i < 8; ++i) { LAS float* d = scr + (kr + 8 * i) * 33 + n4; d[0] = v[i][0]; d[1] = v[i][1]; d[2] = v[i][2]; d[3] = v[i][3]; }
    LDS_WAIT();
    const int c = lane & 7;
#pragma unroll
    for (int j = 0; j < 4; ++j) { const int n = (lane >> 3) + 8 * j; const LAS float* s = scr + (8 * c) * 33 + n;
        u32x4 o; o.x = pk2(s[0 * 33], s[1 * 33]); o.y = pk2(s[2 * 33], s[3 * 33]); o.z = pk2(s[4 * 33], s[5 * 33]); o.w = pk2(s[6 * 33], s[7 * 33]);
        *(u32x4*)(WT + (size_t)(n0 + n) * K + k0 + 8 * c) = o; }
    LDS_WAIT();
}

__device__ __forceinline__ void phase0(const Args& a, LAS unsigned char* lds) {
    const int tid = threadIdx.x, lane = tid & 63, wave = tid >> 6, G = gridDim.x;
    unsigned char* ws = a.ws;
    if (blockIdx.x == 0 && tid < 256) ((unsigned*)(ws + WS_CTL))[tid] = 0u;
    LAS float* scr = (LAS float*)(lds + wave * 16384);
    const int gw = blockIdx.x * 8 + wave, NGW = G * 8;
    for (int it = gw; it < I_IN; it += NGW) p0_transpose_item(a.in[7], DM, PTOT, (bf16_t*)(ws + WS_WIN), scr, it, lane);
    const int gt = blockIdx.x * 512 + tid, NT = G * 512;
    { bf16_t* XB = (bf16_t*)(ws + WS_XB);
      for (int i = gt; i < MT * 256; i += NT) { const int row = i >> 8, c8 = (i & 255) * 8;
          u32x4 o = (u32x4){0u, 0u, 0u, 0u};
          if (row < MR) { const float* src = (row < MP) ? a.in[0] + (size_t)row * DM + c8 : a.in[1] + (size_t)(row - MP) * DM + c8;
              const f32x4 x0 = *(const f32x4*)src, x1 = *(const f32x4*)(src + 4);
              o.x = pk2(x0[0], x0[1]); o.y = pk2(x0[2], x0[3]); o.z = pk2(x1[0], x1[1]); o.w = pk2(x1[2], x1[3]); }
          *(u32x4*)(XB + (size_t)row * DM + c8) = o; } }
    { bf16_t* LT = (bf16_t*)(ws + WS_LORA);
      const float* w2 = a.in[10]; const float* a2 = a.in[12]; const float* g2 = a.in[13];
      for (int i = gt; i < NL * KL; i += NT) { const int n = i / KL, c = i - n * KL; float v = 0.f;
          if (n < 1024) { if (c < 64) v = w2[c * 1024 + n]; }
          else if (n < 2048) { if (c >= 64 && c < 128) v = a2[(c - 64) * 1024 + (n - 1024)]; }
          else { if (c >= 128 && c < 288) v = g2[(c - 128) * 1024 + (n - 2048)]; }
          LT[i] = (bf16_t)f2bf(v); } }
}

__device__ __forceinline__ void phase2(const Args& a) {
    const int tid = threadIdx.x, lane = tid & 63, wave = tid >> 6, G = gridDim.x;
    unsigned char* ws = a.ws;
    const bf16_t* PR = (const bf16_t*)(ws + WS_PR); bf16_t* LIN = (bf16_t*)(ws + WS_LIN);
    const float* mu = a.in[8]; const float* sshift = a.in[6];
    const int gt = blockIdx.x * 512 + tid, NT = G * 512;
    for (int i = gt; i < MT * (KL / 2); i += NT) {
        const int row = i / (KL / 2), j = (i - row * (KL / 2)) * 2;
        unsigned o = 0u;
        if (row < MR && j < 288) {
            const int col = 3072 + j;
            const unsigned pc = *(const unsigned*)(PR + (size_t)row * RPROJ + col);
            const float p0 = bflo(pc), p1 = bfhi(pc);
            float q0 = 0.f, q1 = 0.f;
            const int t = (row < MP) ? (row & (TP - 1)) : ((row - MP) & 15);
            if (t > 0) { const unsigned pp = *(const unsigned*)(PR + (size_t)(row - 1) * RPROJ + col); q0 = bflo(pp); q1 = bfhi(pp); }
            else if (row >= MP) { const float* s = sshift + (size_t)((row - MP) >> 4) * RPROJ + col; q0 = s[0]; q1 = s[1]; }
            const float x0 = p0 + (q0 - p0) * mu[col], x1 = p1 + (q1 - p1) * mu[col + 1];
            float f0, f1;
            if (j < 64) { f0 = tanhf(x0); f1 = tanhf(x1); } else if (j < 128) { f0 = x0; f1 = x1; } else { f0 = sigmoidf_(x0); f1 = sigmoidf_(x1); }
            o = pk2(f0, f1);
        }
        *(unsigned*)(LIN + (size_t)row * KL + j) = o;
    }
    const int gw = blockIdx.x * 8 + wave;
    if (gw < 32) {
        const int b = gw >> 4, h = gw & 15, t0 = lane * 64;
        const float* lf = a.out + OFF_PLOGF + ((size_t)b * TP + t0) * 16 + h;
        float loc = 0.f;
        for (int i = 0; i < 64; ++i) loc += lf[i * 16];
        float inc = loc;
#pragma unroll
        for (int o = 1; o < 64; o <<= 1) { const float n = __shfl_up(inc, o); if (lane >= o) inc += n; }
        float run = inc - loc;
        bf16_t* KE = (bf16_t*)(ws + WS_KE) + ((size_t)gw * TP + t0) * 4;
        for (int i = 0; i < 64; ++i) {
            run += lf[i * 16];
            const float kb = -run * LOG2E;
            const unsigned hi = f2bf(kb); const float r1 = kb - bf2f(hi);
            const unsigned mid = f2bf(r1); const float r2 = r1 - bf2f(mid);
            const unsigned lo = f2bf(r2);
            u32x2 o; o.x = hi | (mid << 16); o.y = lo;
            *(u32x2*)(KE + i * 4) = o;
        }
    }
}

__device__ __forceinline__ void ln_phase(float* Z, const float* g, const float* bta, bf16_t* HB, const float* sbase, const float* slab, const int nslab) {
    const int tid = threadIdx.x, lane = tid & 63, wave = tid >> 6;
    const int gw = blockIdx.x * 8 + wave, NGW = gridDim.x * 8;
    for (int it = gw; it < MT; it += NGW) {
        const int row = (it < 128) ? MP + it : (it < MR ? it - 128 : it);
        if (row >= MR) { if (HB) { u32x4* o = (u32x4*)(HB + (size_t)row * DM); for (int j = 0; j < 4; ++j) o[64 * j + lane] = (u32x4){0u, 0u, 0u, 0u}; } continue; }
        f32x4* zr = (f32x4*)(Z + (size_t)row * DM);
        f32x4 v[8]; float s = 0.f;
        if (row < MP) {
#pragma unroll
            for (int j = 0; j < 8; ++j) v[j] = zr[64 * j + lane];
        } else {
            const f32x4* br = (const f32x4*)(sbase + (size_t)(row - MP) * DM);
#pragma unroll
            for (int j = 0; j < 8; ++j) v[j] = br[64 * j + lane] * ALPHA_RES;
            for (int k = 0; k < nslab; ++k) { const f32x4* sr = (const f32x4*)(slab + ((size_t)k * 128 + (row - MP)) * DM);
#pragma unroll
                for (int j = 0; j < 8; ++j) v[j] += sr[64 * j + lane]; }
        }
#pragma unroll
        for (int j = 0; j < 8; ++j) s += (v[j][0] + v[j][1]) + (v[j][2] + v[j][3]);
        const float mean = wave_sum(s) * (1.f / DM); float s2 = 0.f;
#pragma unroll
        for (int j = 0; j < 8; ++j) { v[j] = v[j] - mean; s2 += (v[j][0] * v[j][0] + v[j][1] * v[j][1]) + (v[j][2] * v[j][2] + v[j][3] * v[j][3]); }
        const float rstd = rsqrtf(wave_sum(s2) * (1.f / DM) + 1e-5f);
#pragma unroll
        for (int j = 0; j < 8; ++j) {
            const f32x4 gg = ((const f32x4*)g)[64 * j + lane], bb = ((const f32x4*)bta)[64 * j + lane];
            const f32x4 y = v[j] * rstd * gg + bb;
            zr[64 * j + lane] = y;
            if (HB) { u32x2 o; o.x = pk2(y[0], y[1]); o.y = pk2(y[2], y[3]); *(u32x2*)(HB + (size_t)row * DM + (64 * j + lane) * 4) = o; }
        }
    }
}

__device__ __forceinline__ float row32_sum(float x) {
    x = row16_sum(x);
    float xa = x, xb = x;
    asm volatile("s_nop 1\n\tv_permlane32_swap_b32 %0, %1" : "+v"(xa), "+v"(xb));
    return xa + xb;
}
__device__ __forceinline__ float half32_sum(float x) {
    x = row16_sum(x);
    return x + __shfl_xor(x, 16);
}
template <bool SAMPLE>
__device__ __forceinline__ void scan_unit(const Args& a, unsigned char* lds, int b, int h, int qt, int sbi) {
    constexpr int TC = SAMPLE ? 16 : 32, NCH = SAMPLE ? 1 : (TP / 32), NS = TC / 8;
    const int tid = threadIdx.x, lane = tid & 63, w = __builtin_amdgcn_readfirstlane(tid >> 6);
    const size_t rowbase = SAMPLE ? (size_t)(MP + b * 16) : (size_t)b * TP;
    unsigned char* ws = a.ws;
    float* buf = (float*)lds;
    if (w < 4) {
        const int s = lane & 15, row = qt * 16 + w * 4 + (lane >> 4);
        bf16_t* YM = (bf16_t*)(ws + WS_YMIX) + rowbase * DM + h * 64 + row;
        typedef float f32x2 __attribute__((ext_vector_type(2)));
        f32x2 S01 = (f32x2){0.f, 0.f}, S23 = (f32x2){0.f, 0.f};
        if (SAMPLE) { const f32x4 x = *(const f32x4*)(a.in[5] + ((size_t)(b * 16 + h) * 64 + row) * 64 + 4 * s); S01 = x.lo; S23 = x.hi; }
        __syncthreads();
        for (int n = 0; n < NCH; ++n) {
            const float* bb = buf + (n & 1) * (TC * 384);
#pragma unroll 1
            for (int hf = 0; hf < TC / 16; ++hf) {
                float yk = 0.f;
#pragma unroll 8
                for (int st = 0; st < 16; ++st) {
                    const float* p = bb + (hf * 16 + st) * 384;
                    const f32x4 w4 = *(const f32x4*)(p + 4 * s), kh4 = *(const f32x4*)(p + 64 + 4 * s), a4 = *(const f32x4*)(p + 128 + 4 * s), b4 = *(const f32x4*)(p + 192 + 4 * s), r4 = *(const f32x4*)(p + 256 + 4 * s);
                    const float v = p[320 + row];
                    const f32x2 vv = (f32x2){v, v};
                    const f32x2 pv = S01 * a4.lo + S23 * a4.hi;
                    const f32x2 u01 = S01 * w4.lo + vv * kh4.lo, u23 = S23 * w4.hi + vv * kh4.hi;
                    const float sa = row16_sum(pv.x + pv.y);
                    const f32x2 sv = (f32x2){sa, sa};
                    S01 = sv * b4.lo + u01; S23 = sv * b4.hi + u23;
                    const f32x2 qv = S01 * r4.lo + S23 * r4.hi;
                    const float y = row16_sum(qv.x + qv.y);
                    yk = (s == st) ? y : yk;
                }
                YM[((size_t)n * TC + hf * 16 + s) * DM] = (bf16_t)f2bf(yk);
            }
            __syncthreads();
        }
        *(f32x4*)(a.out + (SAMPLE ? OFF_SWKV : OFF_PWKV) + ((size_t)(b * 16 + h) * 64 + row) * 64 + 4 * s) = (f32x4){S01.x, S01.y, S23.x, S23.y};
    } else {
        const bf16_t* PR = (const bf16_t*)(ws + WS_PR); const float* Wd = (const float*)(ws + WS_W); const bf16_t* ALR = (const bf16_t*)(ws + WS_ALR);
        const int ptid = tid - 256, pst = ptid >> 5, cp = ptid & 31, ch = h * 64 + 2 * cp;
        const float mur0 = a.in[8][ch], mur1 = a.in[8][ch + 1], muk0 = a.in[8][1024 + ch], muk1 = a.in[8][1025 + ch], muv0 = a.in[8][2048 + ch], muv1 = a.in[8][2049 + ch];
        const float kk0 = a.in[14][ch], kk1 = a.in[14][ch + 1], ka0 = a.in[15][ch], ka1 = a.in[15][ch + 1];
        unsigned rc[NS], kc[NS], vc[NS], rp[NS], kp[NS], vp[NS], al[NS]; float w0[NS], w1[NS];
#define SCAN_LOAD(n) do { _Pragma("unroll") for (int i_ = 0; i_ < NS; ++i_) { const int st_ = pst + 8 * i_; const size_t row_ = rowbase + (size_t)(n) * TC + st_; const bf16_t* pr_ = PR + row_ * RPROJ + ch; \
        rc[i_] = *(const unsigned*)pr_; kc[i_] = *(const unsigned*)(pr_ + 1024); vc[i_] = *(const unsigned*)(pr_ + 2048); \
        if ((n) > 0 || st_ > 0) { rp[i_] = *(const unsigned*)(pr_ - RPROJ); kp[i_] = *(const unsigned*)(pr_ - RPROJ + 1024); vp[i_] = *(const unsigned*)(pr_ - RPROJ + 2048); } else { rp[i_] = 0u; kp[i_] = 0u; vp[i_] = 0u; } \
        { const float* wp_ = Wd + row_ * 1024 + ch; w0[i_] = wp_[0]; w1[i_] = wp_[1]; } al[i_] = *(const unsigned*)(ALR + row_ * 1024 + ch); } } while (0)
#define SCAN_PREP(n) do { _Pragma("unroll") for (int i_ = 0; i_ < NS; ++i_) { const int st_ = pst + 8 * i_; float* bb_ = buf + ((n) & 1) * (TC * 384) + st_ * 384; \
        const float r0_ = bflo(rc[i_]), r1_ = bfhi(rc[i_]), k0_ = bflo(kc[i_]), k1_ = bfhi(kc[i_]), v0_ = bflo(vc[i_]), v1_ = bfhi(vc[i_]); \
        float rq0 = bflo(rp[i_]), rq1 = bfhi(rp[i_]), kq0 = bflo(kp[i_]), kq1 = bfhi(kp[i_]), vq0 = bflo(vp[i_]), vq1 = bfhi(vp[i_]); \
        if (SAMPLE && (n) == 0 && st_ == 0) { const float* sh_ = a.in[6] + (size_t)b * RPROJ + ch; rq0 = sh_[0]; rq1 = sh_[1]; kq0 = sh_[1024]; kq1 = sh_[1025]; vq0 = sh_[2048]; vq1 = sh_[2049]; } \
        const float rs0 = r0_ + (rq0 - r0_) * mur0, rs1 = r1_ + (rq1 - r1_) * mur1, ks0 = k0_ + (kq0 - k0_) * muk0, ks1 = k1_ + (kq1 - k1_) * muk1; \
        const float vs0 = v0_ + (vq0 - v0_) * muv0, vs1 = v1_ + (vq1 - v1_) * muv1; \
        const float n0_ = ks0 * kk0, n1_ = ks1 * kk1; const float ss_ = half32_sum(n0_ * n0_ + n1_ * n1_); const float inv_ = 1.0f / fmaxf(sqrtf(ss_), 1e-12f); \
        const float kn0 = n0_ * inv_, kn1 = n1_ * inv_, al0 = bflo(al[i_]), al1 = bfhi(al[i_]); \
        const float kh0 = ks0 * (1.0f + (al0 - 1.0f) * ka0), kh1 = ks1 * (1.0f + (al1 - 1.0f) * ka1); \
        *(float2*)(bb_ + 2 * cp) = make_float2(w0[i_], w1[i_]); *(float2*)(bb_ + 64 + 2 * cp) = make_float2(kh0, kh1); *(float2*)(bb_ + 128 + 2 * cp) = make_float2(-kn0, -kn1); \
        *(float2*)(bb_ + 192 + 2 * cp) = make_float2(kn0 * al0, kn1 * al1); *(float2*)(bb_ + 256 + 2 * cp) = make_float2(rs0, rs1); *(float2*)(bb_ + 320 + 2 * cp) = make_float2(vs0, vs1); } } while (0)
        SCAN_LOAD(0); SCAN_PREP(0);
        if (NCH > 1) SCAN_LOAD(1);
        LAS float* tscr = (LAS float*)((LAS unsigned char*)lds + 98304 + (w - 4) * 8448);
        f32x4 tv[8]; int tit = -1; const int pw = sbi * 4 + (w - 4);
        __syncthreads();
        for (int n = 0; n < NCH; ++n) {
            if (!SAMPLE && tit >= 0) late_item_finish(a, tit, lane, tv, tscr);
            if (n + 1 < NCH) { SCAN_PREP(n + 1); if (n + 2 < NCH) SCAN_LOAD(n + 2); }
            if (!SAMPLE) { tit = pw + 512 * n; if (tit < I_O + I_UP + I_DN) late_item_load(a, tit, lane, tv); else tit = -1; }
            __syncthreads();
        }
        if (!SAMPLE && tit >= 0) late_item_finish(a, tit, lane, tv, tscr);
#undef SCAN_LOAD
#undef SCAN_PREP
    }
}

__device__ __forceinline__ void phase_gn(const Args& a) {
    const int tid = threadIdx.x, lane = tid & 63, wave = tid >> 6;
    const int gw = blockIdx.x * 8 + wave, NGW = gridDim.x * 8;
    unsigned char* ws = a.ws;
    const bf16_t* PR = (const bf16_t*)(ws + WS_PR); const bf16_t* ALR = (const bf16_t*)(ws + WS_ALR); const bf16_t* Gt = (const bf16_t*)(ws + WS_G); bf16_t* YM = (bf16_t*)(ws + WS_YMIX);
    const float* mu = a.in[8];
    for (int item = gw; item < MR * 16; item += NGW) {
        const int row = item >> 4, h = item & 15, ch = h * 64 + lane;
        const int t = (row < MP) ? (row & (TP - 1)) : ((row - MP) & 15);
        const float y = bf2f(YM[(size_t)row * DM + ch]);
        const bf16_t* pr = PR + (size_t)row * RPROJ + ch;
        const float r = bf2f(pr[0]), k = bf2f(pr[1024]), v = bf2f(pr[2048]);
        float rq = 0.f, kq = 0.f, vq = 0.f;
        if (t > 0) { rq = bf2f(pr[-RPROJ]); kq = bf2f(pr[1024 - RPROJ]); vq = bf2f(pr[2048 - RPROJ]); }
        else if (row >= MP) { const float* sh = a.in[6] + (size_t)((row - MP) >> 4) * RPROJ + ch; rq = sh[0]; kq = sh[1024]; vq = sh[2048]; }
        const float rs = r + (rq - r) * mu[ch], ks = k + (kq - k) * mu[1024 + ch], vs = v + (vq - v) * mu[2048 + ch];
        const float alr = bf2f(ALR[(size_t)row * 1024 + ch]);
        const float kh = ks * (1.0f + (alr - 1.0f) * a.in[15][ch]);
        const float bo = wave_sum(rs * kh * a.in[16][ch]);
        const float mean = wave_sum(y) * (1.f / 64.f); const float d = y - mean;
        const float var = wave_sum(d * d) * (1.f / 64.f); const float rstd = rsqrtf(var + 64e-5f);
        const float o = (d * rstd * a.in[17][ch] + a.in[18][ch] + bo * vs) * bf2f(Gt[(size_t)row * 1024 + ch]);
        YM[(size_t)row * DM + ch] = (bf16_t)f2bf(o);
    }
}

__device__ __forceinline__ int crow(int r, int hi) { return (r & 3) + 8 * (r >> 2) + 4 * hi; }
__device__ __forceinline__ void attn_unit(const Args& a, unsigned char* lds, int bh, int qb) {
    const int tid = threadIdx.x, lane = tid & 63, w = tid >> 6, r32 = lane & 31, hi = lane >> 5;
    const int b = bh >> 4, h = bh & 15;
    unsigned char* ws = a.ws;
    const bf16_t* Q = (const bf16_t*)(ws + WS_Q); const bf16_t* KB = (const bf16_t*)(ws + WS_KB); const bf16_t* VT = (const bf16_t*)(ws + WS_VT);
    const bf16_t* KE = (const bf16_t*)(ws + WS_KE); const bf16_t* OG = (const bf16_t*)(ws + WS_OG); bf16_t* YM = (bf16_t*)(ws + WS_YMIX);
    bf16_t* Kt = (bf16_t*)lds;
    bf16_t* Vt = (bf16_t*)(lds + 18432);
    bf16_t* Et = (bf16_t*)(lds + 18432 + 17408);
    const size_t tokbase = (size_t)b * TP;
    const int q0 = qb * 256 + w * 32;
    bf16x8 qf[4];
    { const bf16_t* qp = Q + (tokbase + q0 + r32) * 1024 + h * 64 + hi * 8;
#pragma unroll
      for (int s = 0; s < 4; ++s) qf[s] = *(const bf16x8*)(qp + 16 * s); }
    bf16x8 qx = (bf16x8){0, 0, 0, 0, 0, 0, 0, 0};
    if (hi == 0) { qx[0] = (short)0x3F80; qx[1] = (short)0x3F80; qx[2] = (short)0x3F80; }
    f32x16 ot0, ot1;
#pragma unroll
    for (int r = 0; r < 16; ++r) { ot0[r] = 0.f; ot1[r] = 0.f; }
    float mrun = -INFINITY, lrun = 0.f;
    const int NT = 4 * (qb + 1);
    const int srow = tid >> 3, sch = tid & 7;
    const bf16_t* kg = KB + (tokbase + srow) * 1024 + h * 64 + sch * 8;
    const bf16_t* vg = VT + ((size_t)bh * 64 + srow) * TP + sch * 8;
    const bf16_t* eg = KE + ((size_t)bh * TP + (tid & 63)) * 4;
    u32x4 kreg, vreg; u32x2 ereg = (u32x2){0u, 0u};
#define ATT_LOAD(t) do { kreg = *(const u32x4*)(kg + (size_t)(t) * 64 * 1024); vreg = *(const u32x4*)(vg + (t) * 64); if (tid < 64) ereg = *(const u32x2*)(eg + (t) * 64 * 4); } while (0)
#define ATT_WRITE(bufi) do { *(u32x4*)(Kt + (bufi) * 4608 + srow * 72 + sch * 8) = kreg; \
        *(u32x2*)(Vt + (bufi) * 4352 + srow * 68 + sch * 8) = (u32x2){vreg.x, vreg.y}; *(u32x2*)(Vt + (bufi) * 4352 + srow * 68 + sch * 8 + 4) = (u32x2){vreg.z, vreg.w}; \
        if (tid < 64) *(u32x2*)(Et + (bufi) * 256 + tid * 4) = ereg; } while (0)
    ATT_LOAD(0); ATT_WRITE(0);
    __syncthreads();
    for (int t = 0; t < NT; ++t) {
        const int cur = t & 1;
        if (t + 1 < NT) ATT_LOAD(t + 1);
        if (64 * t <= q0 + 31) {
            const bf16_t* kb_ = Kt + cur * 4608; const bf16_t* vb_ = Vt + cur * 4352; const bf16_t* eb_ = Et + cur * 256;
            f32x16 st0, st1;
#pragma unroll
            for (int r = 0; r < 16; ++r) { st0[r] = 0.f; st1[r] = 0.f; }
#pragma unroll
            for (int s = 0; s < 4; ++s) {
                const bf16x8 k0 = *(const bf16x8*)(kb_ + r32 * 72 + 16 * s + 8 * hi), k1 = *(const bf16x8*)(kb_ + (32 + r32) * 72 + 16 * s + 8 * hi);
                st0 = __builtin_amdgcn_mfma_f32_32x32x16_bf16(k0, qf[s], st0, 0, 0, 0);
                st1 = __builtin_amdgcn_mfma_f32_32x32x16_bf16(k1, qf[s], st1, 0, 0, 0);
            }
            {
                bf16x8 e0 = (bf16x8){0, 0, 0, 0, 0, 0, 0, 0}, e1 = e0;
                if (hi == 0) {
                    const u32x2 x0 = *(const u32x2*)(eb_ + r32 * 4), x1 = *(const u32x2*)(eb_ + (32 + r32) * 4);
                    e0[0] = (short)(x0.x & 0xffffu); e0[1] = (short)(x0.x >> 16); e0[2] = (short)(x0.y & 0xffffu);
                    e1[0] = (short)(x1.x & 0xffffu); e1[1] = (short)(x1.x >> 16); e1[2] = (short)(x1.y & 0xffffu);
                }
                st0 = __builtin_amdgcn_mfma_f32_32x32x16_bf16(e0, qx, st0, 0, 0, 0);
                st1 = __builtin_amdgcn_mfma_f32_32x32x16_bf16(e1, qx, st1, 0, 0, 0);
            }
            if (64 * t + 63 > q0) {
                const int qi = q0 + r32;
#pragma unroll
                for (int r = 0; r < 16; ++r) { const int kv = 64 * t + crow(r, hi); if (kv > qi) st0[r] = -INFINITY; if (kv + 32 > qi) st1[r] = -INFINITY; }
            }
            float mx = fmaxf(st0[0], st1[0]);
#pragma unroll
            for (int r = 1; r < 16; ++r) mx = fmaxf(mx, fmaxf(st0[r], st1[r]));
            mx = fmaxf(mx, __shfl_xor(mx, 32));
            const float mnew = fmaxf(mrun, mx);
            const float alpha = __builtin_amdgcn_exp2f(mrun - mnew);
            mrun = mnew;
            float rs = 0.f;
#pragma unroll
            for (int r = 0; r < 16; ++r) { st0[r] = __builtin_amdgcn_exp2f(st0[r] - mnew); st1[r] = __builtin_amdgcn_exp2f(st1[r] - mnew); rs += st0[r] + st1[r]; }
            lrun = lrun * alpha + rs;
#pragma unroll
            for (int r = 0; r < 16; ++r) { ot0[r] *= alpha; ot1[r] *= alpha; }
#pragma unroll
            for (int sp = 0; sp < 4; ++sp) {
                const int base = 8 * (sp & 1);
                u32x4 pw;
                if (sp < 2) { pw.x = cvt_pk_bf16(st0[base + 0], st0[base + 1]); pw.y = cvt_pk_bf16(st0[base + 2], st0[base + 3]); pw.z = cvt_pk_bf16(st0[base + 4], st0[base + 5]); pw.w = cvt_pk_bf16(st0[base + 6], st0[base + 7]); }
                else        { pw.x = cvt_pk_bf16(st1[base + 0], st1[base + 1]); pw.y = cvt_pk_bf16(st1[base + 2], st1[base + 3]); pw.z = cvt_pk_bf16(st1[base + 4], st1[base + 5]); pw.w = cvt_pk_bf16(st1[base + 6], st1[base + 7]); }
                const bf16x8 pf = __builtin_bit_cast(bf16x8, pw);
                {
                    const bf16_t* vp = vb_ + r32 * 68 + 16 * sp + 4 * hi;
                    const u32x2 lo = *(const u32x2*)vp, hi2 = *(const u32x2*)(vp + 8);
                    const bf16x8 vf = __builtin_bit_cast(bf16x8, (u32x4){lo.x, lo.y, hi2.x, hi2.y});
                    ot0 = __builtin_amdgcn_mfma_f32_32x32x16_bf16(vf, pf, ot0, 0, 0, 0);
                }
                {
                    const bf16_t* vp = vb_ + (32 + r32) * 68 + 16 * sp + 4 * hi;
                    const u32x2 lo = *(const u32x2*)vp, hi2 = *(const u32x2*)(vp + 8);
                    const bf16x8 vf = __builtin_bit_cast(bf16x8, (u32x4){lo.x, lo.y, hi2.x, hi2.y});
                    ot1 = __builtin_amdgcn_mfma_f32_32x32x16_bf16(vf, pf, ot1, 0, 0, 0);
                }
            }
        }
        if (t + 1 < NT) ATT_WRITE(cur ^ 1);
        __syncthreads();
    }
#undef ATT_LOAD
#undef ATT_WRITE
    {
        const float lt = lrun + __shfl_xor(lrun, 32); const float inv = 1.0f / lt;
        float ss = 0.f;
#pragma unroll
        for (int r = 0; r < 16; ++r) { ot0[r] *= inv; ot1[r] *= inv; ss += ot0[r] * ot0[r] + ot1[r] * ot1[r]; }
        ss += __shfl_xor(ss, 32);
        const float rinv = rsqrtf(ss * (1.f / 64.f) + 1e-6f);
        const size_t row = tokbase + q0 + r32;
        const float* fog = a.in[20];
#pragma unroll
        for (int dh = 0; dh < 2; ++dh)
#pragma unroll
            for (int g = 0; g < 4; ++g) {
                const int col = h * 64 + 32 * dh + 8 * g + 4 * hi;
                const u32x2 og = *(const u32x2*)(OG + row * 1024 + col); const f32x4 gg = *(const f32x4*)(fog + col);
                float o[4];
#pragma unroll
                for (int j = 0; j < 4; ++j) o[j] = (dh == 0 ? ot0[4 * g + j] : ot1[4 * g + j]) * rinv * gg[j];
                u32x2 wv; wv.x = pk2(o[0] * bflo(og.x), o[1] * bfhi(og.x)); wv.y = pk2(o[2] * bflo(og.y), o[3] * bfhi(og.y));
                *(u32x2*)(YM + row * DM + 1024 + col) = wv;
            }
    }
}

__device__ __forceinline__ void sattn_unit(const Args& a, unsigned char* lds, int bh) {
    const int tid = threadIdx.x, lane = tid & 63, w = tid >> 6;
    const int b = bh >> 4, h = bh & 15;
    unsigned char* ws = a.ws;
    const bf16_t* Q = (const bf16_t*)(ws + WS_Q); const bf16_t* OG = (const bf16_t*)(ws + WS_OG); bf16_t* YM = (bf16_t*)(ws + WS_YMIX);
    const float* ck = a.in[2]; const float* cv = a.in[3]; const float* clf = a.in[4];
    float* qs = (float*)lds;
    float* cb = qs + 1024;
    float* sc = cb + 1088;
    float* red = sc + 16640;
    for (int i = tid; i < 1024; i += 512) { const int q = i >> 6, d = i & 63; qs[i] = bf2f(Q[(size_t)(MP + b * 16 + q) * 1024 + h * 64 + d]); }
    if (w == 0) {
        const int e0 = lane * 17; float loc = 0.f;
        for (int i = 0; i < 17; ++i) { const int e = e0 + i; if (e < 1040) loc += (e < 1024) ? clf[((size_t)b * 1024 + e) * 16 + h] : a.out[OFF_SLOGF + (size_t)(b * 16 + e - 1024) * 16 + h]; }
        float inc = loc;
#pragma unroll
        for (int o = 1; o < 64; o <<= 1) { const float n = __shfl_up(inc, o); if (lane >= o) inc += n; }
        float run = inc - loc;
        for (int i = 0; i < 17; ++i) { const int e = e0 + i; if (e < 1040) { run += (e < 1024) ? clf[((size_t)b * 1024 + e) * 16 + h] : a.out[OFF_SLOGF + (size_t)(b * 16 + e - 1024) * 16 + h]; cb[e] = -run * LOG2E; } }
    }
    __syncthreads();
#pragma unroll 1
    for (int it = 0; it < 3; ++it) {
        const int j = tid + 512 * it;
        if (j < 1040) {
            const float* kp = (j < 1024) ? ck + (((size_t)b * 1024 + j) * 16 + h) * 64 : a.out + OFF_SK + ((size_t)(b * 16 + j - 1024) * 16 + h) * 64;
            f32x4 kv[16];
#pragma unroll
            for (int i = 0; i < 16; ++i) kv[i] = *(const f32x4*)(kp + 4 * i);
            const float bias = cb[j];
#pragma unroll 1
            for (int q = 0; q < 16; ++q) {
                const f32x4* qp = (const f32x4*)(qs + q * 64);
                float d0 = 0.f, d1 = 0.f;
#pragma unroll
                for (int i = 0; i < 16; i += 2) { const f32x4 x = qp[i], y = qp[i + 1];
                    d0 += x[0] * kv[i][0] + x[1] * kv[i][1] + x[2] * kv[i][2] + x[3] * kv[i][3];
                    d1 += y[0] * kv[i + 1][0] + y[1] * kv[i + 1][1] + y[2] * kv[i + 1][2] + y[3] * kv[i + 1][3]; }
                float sv = d0 + d1 + bias;
                if (j >= 1024 && j - 1024 > q) sv = -INFINITY;
                sc[q * 1040 + j] = sv;
            }
        }
    }
    __syncthreads();
    for (int qq = 0; qq < 2; ++qq) {
        float* sr = sc + (2 * w + qq) * 1040;
        float mx = -INFINITY;
        for (int j = lane; j < 1040; j += 64) mx = fmaxf(mx, sr[j]);
        mx = wave_max(mx);
        float sum = 0.f;
        for (int j = lane; j < 1040; j += 64) { const float p = __builtin_amdgcn_exp2f(sr[j] - mx); sr[j] = p; sum += p; }
        sum = wave_sum(sum);
        const float inv = 1.0f / sum;
        for (int j = lane; j < 1040; j += 64) sr[j] *= inv;
    }
    __syncthreads();
    {
        float acc[16];
#pragma unroll
        for (int q = 0; q < 16; ++q) acc[q] = 0.f;
        const float* vbase = cv + (((size_t)b * 1024) * 16 + h) * 64 + lane;
#pragma unroll 16
        for (int j = w; j < 1024; j += 8) {
            const float vv = vbase[(size_t)j * 1024];
#pragma unroll
            for (int q = 0; q < 16; ++q) acc[q] = fmaf(sc[q * 1040 + j], vv, acc[q]);
        }
        for (int j = 1024 + w; j < 1040; j += 8) {
            const float vv = a.out[OFF_SV + ((size_t)(b * 16 + j - 1024) * 16 + h) * 64 + lane];
#pragma unroll
            for (int q = 0; q < 16; ++q) acc[q] = fmaf(sc[q * 1040 + j], vv, acc[q]);
        }
#pragma unroll
        for (int q = 0; q < 16; ++q) red[(w * 16 + q) * 64 + lane] = acc[q];
    }
    __syncthreads();
    for (int pass = 0; pass < 2; ++pass) {
        const int q = w + 8 * pass;
        float o = 0.f;
#pragma unroll
        for (int ww = 0; ww < 8; ++ww) o += red[(ww * 16 + q) * 64 + lane];
        const float ss = wave_sum(o * o);
        const float rinv = rsqrtf(ss * (1.f / 64.f) + 1e-6f);
        const size_t row = (size_t)(MP + b * 16 + q); const int col = h * 64 + lane;
        const float y = o * rinv * a.in[20][col] * bf2f(OG[row * 1024 + col]);
        YM[row * DM + 1024 + col] = (bf16_t)f2bf(y);
    }
    __syncthreads();
}

__device__ __forceinline__ int next_work(unsigned* ctr, unsigned char* lds) {
    volatile unsigned* wordp = (volatile unsigned*)(lds + LDS_WORD_OFF);
    if (threadIdx.x == 0) *wordp = __hip_atomic_fetch_add(ctr, 1u, __ATOMIC_RELAXED, __HIP_MEMORY_SCOPE_AGENT);
    __syncthreads();
    const int v = (int)*wordp;
    __syncthreads();
    return v;
}

__device__ __forceinline__ void sample_up_small(const Args& a) {
    const int tid = threadIdx.x, lane = tid & 63, w = tid >> 6, fr = lane & 15, fq = lane >> 4;
    unsigned char* ws = a.ws;
    const bf16_t* HBr = (const bf16_t*)(ws + WS_HB) + (size_t)(MP + 16 * w + fr) * DM + 8 * fq;
    bf16_t* U = (bf16_t*)(ws + WS_U);
    for (int cb = blockIdx.x; cb < DFF / 32; cb += gridDim.x) {
        const bf16_t* B0 = (const bf16_t*)(ws + WS_WUP) + (size_t)(32 * cb + fr) * DM + 8 * fq;
        const bf16_t* B1 = B0 + (size_t)16 * DM;
        f32x4 acc0 = (f32x4){0.f, 0.f, 0.f, 0.f}, acc1 = acc0;
#pragma unroll 8
        for (int kk = 0; kk < DM / 32; ++kk) {
            const bf16x8 av = *(const bf16x8*)(HBr + 32 * kk), b0 = *(const bf16x8*)(B0 + 32 * kk), b1 = *(const bf16x8*)(B1 + 32 * kk);
            acc0 = __builtin_amdgcn_mfma_f32_16x16x32_bf16(av, b0, acc0, 0, 0, 0);
            acc1 = __builtin_amdgcn_mfma_f32_16x16x32_bf16(av, b1, acc1, 0, 0, 0);
        }
#pragma unroll
        for (int r = 0; r < 4; ++r) {
            bf16_t* o = U + (size_t)(MP + 16 * w + 4 * fq + r) * DFF + 32 * cb + fr;
            const float x0 = fmaxf(acc0[r], 0.f), x1 = fmaxf(acc1[r], 0.f);
            o[0] = (bf16_t)f2bf(x0 * x0); o[16] = (bf16_t)f2bf(x1 * x1);
        }
    }
}

#define GAS __attribute__((address_space(1)))
#define RLX_AGENT __ATOMIC_RELAXED, __HIP_MEMORY_SCOPE_AGENT
#define XB_TMO      128
#define XB_XCNT(j)  (256  + 64 * (j))
#define XB_XSUB(j)  (1280 + 64 * (j))
#define XB_XGEN(j)  (2304 + 64 * (j))
#define XB_TOP      3328
#define XB_TOPGEN   3392
#define XCD_BAR_WORDS 3456
#define XB_SPIN_CAP (1u << 18)

__device__ __forceinline__ unsigned xb_ld(unsigned* p)              { return __hip_atomic_load(p, __ATOMIC_RELAXED, __HIP_MEMORY_SCOPE_AGENT); }
__device__ __forceinline__ unsigned xb_add(unsigned* p, unsigned v) { return __hip_atomic_fetch_add(p, v, __ATOMIC_RELAXED, __HIP_MEMORY_SCOPE_AGENT); }
__device__ __forceinline__ unsigned xb_xcc_id() { return (unsigned)__builtin_amdgcn_s_getreg((3 << 11) | 20) & 0xFu; }
#define XB_SPIN(cond, bar) do { unsigned _sp = 0; while (cond) { __builtin_amdgcn_s_sleep(1); \
    if ((++_sp & 255u) == 0u) { if (xb_ld(&(bar)[XB_TMO])) break; if (_sp > XB_SPIN_CAP) { atomicAdd(&(bar)[XB_TMO], 1u); break; } } } } while (0)

struct XcdBarrier {
    unsigned* bar; unsigned x;
    volatile LAS unsigned* st;
};

__device__ __forceinline__ XcdBarrier xcd_barrier_post(unsigned* bar, volatile LAS unsigned* st) {
    XcdBarrier b; b.bar = bar; b.x = xb_xcc_id(); b.st = st;
    if (threadIdx.x == 0) (void)xb_add(&bar[XB_XCNT(b.x)], 1u);
    return b;
}
__device__ __forceinline__ void xcd_barrier_complete(unsigned* bar, unsigned x, unsigned& nloc, unsigned& nx) {
    const unsigned G = gridDim.x * gridDim.y * gridDim.z;
    unsigned sum, cnt, mine, sp = 0u;
    for (;;) {
        sum = 0u; cnt = 0u; mine = 0u;
#pragma unroll
        for (unsigned j = 0; j < 16; ++j) { const unsigned c = xb_ld(&bar[XB_XCNT(j)]); sum += c; cnt += (c > 0u) ? 1u : 0u; mine = (j == x) ? c : mine; }
        if (sum == G) break;
        __builtin_amdgcn_s_sleep(1);
        if ((++sp & 255u) == 0u) { if (xb_ld(&bar[XB_TMO])) break; if (sp > XB_SPIN_CAP) { atomicAdd(&bar[XB_TMO], 1u); break; } }
    }
    nloc = mine > 0u ? mine : 1u; nx = cnt > 0u ? cnt : 1u;
}

__device__ __forceinline__ void xcd_barrier(const XcdBarrier& b) {
    asm volatile("s_waitcnt vmcnt(0)" ::: "memory");
    __syncthreads();
    if (threadIdx.x == 0) {
        unsigned* bar = b.bar;
        __builtin_amdgcn_s_waitcnt(0);
        unsigned nloc = b.st[0], nx = b.st[1];
        if (nloc == 0u) { xcd_barrier_complete(bar, b.x, nloc, nx); b.st[0] = nloc; b.st[1] = nx; }
        const unsigned old = xb_add(&bar[XB_XSUB(b.x)], 1u);
        const unsigned gen = old / nloc;
        if (old + 1u == (gen + 1u) * nloc) {
            __builtin_amdgcn_fence(__ATOMIC_RELEASE, "agent");
            asm volatile("s_waitcnt vmcnt(0)" ::: "memory");
            const unsigned og = xb_add(&bar[XB_TOP], 1u);
            const unsigned tg = og / nx;
            if (og + 1u == (tg + 1u) * nx) xb_add(&bar[XB_TOPGEN], 1u);
            else XB_SPIN(xb_ld(&bar[XB_TOPGEN]) == tg, bar);
            __builtin_amdgcn_fence(__ATOMIC_ACQUIRE, "agent");
            xb_add(&bar[XB_XGEN(b.x)], 1u);
            asm volatile("s_waitcnt vmcnt(0)" ::: "memory");
        } else {
            XB_SPIN(xb_ld(&bar[XB_XGEN(b.x)]) == gen, bar);
            __builtin_amdgcn_fence(__ATOMIC_ACQUIRE, "agent");
            asm volatile("s_waitcnt vmcnt(0)" ::: "memory");
        }
    }
    __syncthreads();
}

__global__ void __launch_bounds__(512, 2) mk_fwd(Args a) {
    extern __shared__ __attribute__((aligned(16))) unsigned char lds[];
    LAS unsigned char* ldsl = (LAS unsigned char*)lds;
    const int lo = a.ph_lo, hi = a.ph_hi, G = gridDim.x;
    unsigned char* ws = a.ws;
#ifndef PH_MASK
#define PH_MASK 0x7ff
#endif
#define IN(k) (((PH_MASK >> (k)) & 1) && lo <= (k) && (k) < hi)
    if (threadIdx.x < 4) ((LAS unsigned*)(ldsl + LDS_BARW_OFF))[threadIdx.x] = 0u;
    __syncthreads();
    XcdBarrier bar = xcd_barrier_post((unsigned*)(ws + WS_CTL) + CW_BAR, (volatile LAS unsigned*)(ldsl + LDS_BARW_OFF));
    if (a.ph_hi > 1000) cg::this_grid().sync();
#define SEAM(k) do { if (IN(k) && IN((k) + 1)) xcd_barrier(bar); } while (0)
    if (IN(0)) { phase0(a, ldsl); }
    SEAM(0);
    if (IN(1)) {
        Gemm g{(const bf16_t*)(ws + WS_XB), (const bf16_t*)(ws + WS_WIN), MT, NIN, DM}; StaticOrder S; S.init(MT, NIN, DM, G, (int)blockIdx.x);
        EpiIn E{(bf16_t*)(ws + WS_PR), (bf16_t*)(ws + WS_Q), (bf16_t*)(ws + WS_KB), (bf16_t*)(ws + WS_VT), (bf16_t*)(ws + WS_OG), a.out, a.in[19]};
        gemm_phase<EpiIn, StaticOrder, true, true>(ldsl, g, S, E);
    }
    SEAM(1);
    if (IN(2)) { phase2(a); }
    SEAM(2);
    if (IN(3)) {
        Gemm g{(const bf16_t*)(ws + WS_LIN), (const bf16_t*)(ws + WS_LORA), MT, NL, KL}; StaticOrder S; S.init(MT, NL, KL, G, (int)blockIdx.x);
        EpiLora E{(float*)(ws + WS_W), (bf16_t*)(ws + WS_ALR), (bf16_t*)(ws + WS_G), a.in[9], a.in[11]};
        gemm_phase<EpiLora, StaticOrder, true, true>(ldsl, g, S, E);
    }
    SEAM(3);
    if (IN(4)) {
        unsigned* ctr = (unsigned*)(ws + WS_CTL) + 128 * a.rep;
        const int pm_ = a.pad ? a.pad : 7;
        if (blockIdx.x < 128) { if (pm_ & 1) { const int sb = (int)blockIdx.x; const int bh = (sb & 7) * 4 + ((sb >> 3) >> 2); scan_unit<false>(a, lds, bh >> 4, bh & 15, (sb >> 3) & 3, sb); } }
        else if (pm_ & 2) { for (;;) { const int i = next_work(ctr, lds); if (i >= 512) break; attn_unit(a, lds, i & 31, 15 - (i >> 5)); } }
        if (pm_ & 4) for (;;) { const int j = next_work(ctr + 64, lds); if (j >= 640) break;
            if (j < 128) sattn_unit(a, lds, j); else { const int u = j - 128; scan_unit<true>(a, lds, u >> 6, (u >> 2) & 15, u & 3, 0); } }
    }
    SEAM(4);
    if (IN(5)) { phase_gn(a); }
    SEAM(5);
    if (IN(6)) {
        Gemm g{(const bf16_t*)(ws + WS_YMIX), (const bf16_t*)(ws + WS_WO), MT, DM, DM}; SplitOrder S; S.init(DM, DM, G, (int)blockIdx.x, 512);
        EpiRes E{a.in[0], a.out, (float*)(ws + WS_SLAB1), 512};
        gemm_phase<EpiRes, SplitOrder, true, true>(ldsl, g, S, E);
    }
    SEAM(6);
    if (IN(7)) { ln_phase(a.out, a.in[22], a.in[23], (bf16_t*)(ws + WS_HB), a.in[1], (const float*)(ws + WS_SLAB1), 4); }
    SEAM(7);
    if (IN(8)) {
        sample_up_small(a);
        Gemm g{(const bf16_t*)(ws + WS_HB), (const bf16_t*)(ws + WS_WUP), MP, DFF, DM}; StaticOrder S; S.init(MP, DFF, DM, G, (int)blockIdx.x);
        EpiUp E{(bf16_t*)(ws + WS_U)};
        gemm_phase<EpiUp, StaticOrder, true, true>(ldsl, g, S, E);
    }
    SEAM(8);
    if (IN(9)) {
        Gemm g{(const bf16_t*)(ws + WS_U), (const bf16_t*)(ws + WS_WDN), MT, DM, DFF}; SplitOrder S; S.init(DM, DFF, G, (int)blockIdx.x, 1024);
        EpiRes E{a.out, a.out, (float*)(ws + WS_SLAB2), 1024};
        gemm_phase<EpiRes, SplitOrder, true, true>(ldsl, g, S, E);
    }
    SEAM(9);
    if (IN(10)) { ln_phase(a.out, a.in[26], a.in[27], nullptr, a.out + OFF_YS, (const float*)(ws + WS_SLAB2), 8); }
#undef IN
#undef SEAM
}
}

extern "C" void kernel_launch(void* const* d_in, const int* in_sizes, int n_in, void* d_out, int out_size, void* d_ws, size_t ws_size, hipStream_t stream) {
    using namespace pg8;
    static int grid = 0;
    if (grid == 0) {
        if (n_in != 28 || (size_t)out_size != OUT_TOTAL || ws_size < WS_END) { fprintf(stderr, "kernel_launch: unexpected problem (n_in %d, out %d, ws %zu); nothing launched\n", n_in, out_size, ws_size); grid = -1; return; }
        int dev = 0, cus = 0, per_cu = 0;
        if (hipGetDevice(&dev) != hipSuccess || hipDeviceGetAttribute(&cus, hipDeviceAttributeMultiprocessorCount, dev) != hipSuccess) { grid = -1; return; }
        if (hipFuncSetAttribute((const void*)mk_fwd, hipFuncAttributeMaxDynamicSharedMemorySize, LDS_BYTES) != hipSuccess) { fprintf(stderr, "kernel_launch: hipFuncSetAttribute failed\n"); grid = -1; return; }
        if (hipOccupancyMaxActiveBlocksPerMultiprocessor(&per_cu, (const void*)mk_fwd, 512, LDS_BYTES) != hipSuccess || per_cu < 1) { fprintf(stderr, "kernel_launch: occupancy query says %d\n", per_cu); per_cu = 1; }
        (void)hipGetLastError();
        grid = cus;
    }
    if (grid < 0) return;
    if (hipMemsetAsync((char*)d_ws + WS_CTL, 0, 65536, stream) != hipSuccess) { fprintf(stderr, "kernel_launch: hipMemsetAsync failed\n"); return; }
    Args a{};
    for (int i = 0; i < 28; ++i) a.in[i] = (const float*)d_in[i];
    a.out = (float*)d_out; a.ws = (unsigned char*)d_ws;
#if ONE_LAUNCH
    a.ph_lo = 0; a.ph_hi = NPH;
    void* args[] = {&a};
    hipError_t e = hipLaunchCooperativeKernel((const void*)mk_fwd, dim3(grid), dim3(512), args, LDS_BYTES, stream);
    if (e != hipSuccess) fprintf(stderr, "kernel_launch: cooperative launch failed: %s (grid %d)\n", hipGetErrorString(e), grid);
#else
#ifndef PROBE_DUP
#define PROBE_DUP -1
#endif
#ifndef PROBE_MODE
#define PROBE_MODE 0
#endif
    for (int p = 0; p < NPH; ++p) { a.ph_lo = p; a.ph_hi = p + 1; a.rep = 0; a.pad = 0; hipLaunchKernelGGL(mk_fwd, dim3(grid), dim3(512), LDS_BYTES, stream, a);
        if (p == PROBE_DUP) { a.rep = 1; a.pad = PROBE_MODE; hipLaunchKernelGGL(mk_fwd, dim3(grid), dim3(512), LDS_BYTES, stream, a); } }
#endif
}
```

```cpp
#include <hip/hip_runtime.h>
#include <hip/hip_cooperative_groups.h>
#include <cstdio>
#include <cstdint>
namespace pg8 {
#define PG8_LAS __attribute__((address_space(3)))
typedef unsigned short bf16_t;
typedef short bf16x8 __attribute__((ext_vector_type(8)));
typedef float f32x4 __attribute__((ext_vector_type(4)));
typedef unsigned u32x4 __attribute__((ext_vector_type(4)));
constexpr int BM = 256, BK = 64, HALF = 128, HTB = HALF * BK * 2  , STAGE_BYTES = 8 * HTB, NXCD = 8, WGM = 8;

__host__ __device__ __forceinline__ int lds_byte(int r, int c) { const int st = (r >> 4) * 2 + (c >> 5), rr = r & 15, cc = c & 31, ob = rr * 64 + cc * 2; return st * 1024 + (ob ^ (((ob >> 9) & 1) << 5)); }
__host__ __device__ __forceinline__ void stage_rc(int b, int& R, int& C) { const int st = b / 1024, sb = b % 1024, swz = sb ^ (((sb >> 9) & 1) << 5); R = (st >> 1) * 16 + swz / 64; C = (st & 1) * 32 + (swz % 64) / 2; }
__host__ __device__ __forceinline__ int perm32(int rho) { const int n = rho >> 4, i = rho & 15; return 8 * (i >> 2) + 4 * n + (i & 3); }

struct Unit { int pm, pn, k0, nt, smp; };
struct Gemm { const bf16_t* A; const bf16_t* Bt; int M, N, K; };

struct StaticOrder {
    int nM, nN, nwg, G, c, ntk;
    __host__ __device__ void init(int M, int N, int K, int G_, int c_) { nM = M / BM; nN = N / BM; nwg = nM * nN; G = G_; c = c_; ntk = K / BK; }
    __host__ __device__ bool next(int i, Unit& u) const {
        const long L = (long)i * G + c; if (L >= nwg) return false;
        int wgid = (int)L; { const int q = nwg / NXCD, r = nwg % NXCD, xcd = wgid % NXCD, off = wgid / NXCD; wgid = (xcd < r ? xcd * (q + 1) : r * (q + 1) + (xcd - r) * q) + off; }
        const int nig = WGM * nN, gid = wgid / nig, fm = gid * WGM, gsz = (nM - fm) < WGM ? (nM - fm) : WGM;
        u.pm = fm + ((wgid % nig) % gsz); u.pn = (wgid % nig) / gsz; u.k0 = 0; u.nt = ntk; u.smp = 0; return true;
    }
    __device__ __forceinline__ void a_ready(const Unit&) const {}
    __device__ __forceinline__ void done(const Unit&) const {}
};

struct SplitOrder {
    StaticOrder P; int nN, nks, KC;
    __host__ __device__ void init(int N, int K, int G_, int c_, int KC_) { P.init(8192, N, K, G_, c_); nN = N / BM; KC = KC_; nks = K / KC_; }
    __host__ __device__ bool next(int i, Unit& u) const {
        const long L = (long)i * P.G + P.c;
        if (L < P.nwg) return P.next(i, u);
        const int idx = (int)(L - P.nwg); if (idx >= nN * nks) return false;
        u.pm = 32; u.pn = idx % nN; u.k0 = (idx / nN) * KC; u.nt = KC / BK; u.smp = 1; return true;
    }
    __device__ __forceinline__ void a_ready(const Unit&) const {}
    __device__ __forceinline__ void done(const Unit&) const {}
};

__device__ __forceinline__ unsigned cvt_pk_bf16(float lo, float hi) { unsigned r; asm volatile("v_cvt_pk_bf16_f32 %0, %1, %2" : "=v"(r) : "v"(lo), "v"(hi)); return r; }
template <class Epi, class Sched, bool ALIGN_EPI = false, bool SP2 = false>
__device__ __forceinline__ void gemm_phase(PG8_LAS unsigned char* lds, const Gemm g, const Sched& S, const Epi& E) {
    const int tid = threadIdx.x, wid = __builtin_amdgcn_readfirstlane(tid >> 6), lane = tid & 63, wr = wid >> 2, wc = wid & 3, fr = lane & 15, fq = lane >> 4;
    const int K = g.K;
    unsigned voffA[2], voffB[2];
#pragma unroll
    for (int i = 0; i < 2; ++i) { int R, C; stage_rc(tid * 16 + i * 8192, R, C); const int Rb = Epi::PERM ? ((R & ~31) + perm32(R & 31)) : R;
        voffA[i] = (unsigned)(R * K + C) * 2u; voffB[i] = (unsigned)(Rb * K + C) * 2u; }
    const size_t kstep = (size_t)(BK * 2);
    const size_t hstep = (size_t)HALF * K * 2;
    const size_t tstep = 2 * hstep;
    const unsigned ldsw = (unsigned)wid * 1024u;
    const int aoff = lds_byte(wr * 64 + fr, fq * 8), boff = lds_byte(wc * 32 + fr, fq * 8);
#define PG8_SA(b, h) (((b) * 2 + (h)) * HTB)
#define PG8_SB(b, h) ((4 + (b) * 2 + (h)) * HTB)
#define PG8_STAGE(bufoff, gbase, voff) do { _Pragma("unroll") for (int _i = 0; _i < 2; ++_i) \
        __builtin_amdgcn_global_load_lds((const unsigned*)((const char*)(gbase) + (voff)[_i]), (PG8_LAS unsigned*)(lds + (bufoff) + ldsw + _i * 8192), 16, 0, 0); } while (0)
#define PG8_LDA(dst, b, h) do { _Pragma("unroll") for (int m = 0; m < 4; ++m) _Pragma("unroll") for (int k = 0; k < 2; ++k) dst[m][k] = *(const PG8_LAS bf16x8*)(lds + PG8_SA(b, h) + aoff + m * 2048 + k * 1024); } while (0)
#define PG8_LDB(dst, b, h) do { _Pragma("unroll") for (int n = 0; n < 2; ++n) _Pragma("unroll") for (int k = 0; k < 2; ++k) dst[n][k] = *(const PG8_LAS bf16x8*)(lds + PG8_SB(b, h) + boff + n * 2048 + k * 1024); } while (0)
#define PG8_MMA(ai, bj, At, Bt) do { __builtin_amdgcn_s_setprio(1); _Pragma("unroll") for (int m = 0; m < 4; ++m) _Pragma("unroll") for (int n = 0; n < 2; ++n) _Pragma("unroll") for (int k = 0; k < 2; ++k) \
        acc[ai][bj][m][n] = __builtin_amdgcn_mfma_f32_16x16x32_bf16(Bt[n][k], At[m][k], acc[ai][bj][m][n], 0, 0, 0); __builtin_amdgcn_s_setprio(0); } while (0)
#define PG8_WAIT_V(n) asm volatile("s_waitcnt vmcnt(" #n ")" ::: "memory")
#define PG8_WAIT_L(n) asm volatile("s_waitcnt lgkmcnt(" #n ")" ::: "memory")
#define PG8_BAR __builtin_amdgcn_s_barrier()
#define PG8_SCHED __builtin_amdgcn_sched_barrier(0)
    Unit cur, nxt; int ui = 0;
    if (!S.next(0, cur)) return;
    f32x4 acc[2][2][4][2];
#pragma unroll
    for (int a = 0; a < 2; ++a)
#pragma unroll
        for (int b = 0; b < 2; ++b)
#pragma unroll
            for (int m = 0; m < 4; ++m)
#pragma unroll
                for (int n = 0; n < 2; ++n) acc[a][b][m][n] = (f32x4){0.f, 0.f, 0.f, 0.f};
    bf16x8 At[4][2], B0[2][2], B1[2][2];
    const char* cA = (const char*)g.A + (size_t)cur.pm * tstep + (size_t)cur.k0 * 2; const char* cB = (const char*)g.Bt + (size_t)cur.pn * tstep + (size_t)cur.k0 * 2;
    S.a_ready(cur);
    if constexpr (SP2) {
        PG8_STAGE(PG8_SB(0, 0), cB, voffB); PG8_STAGE(PG8_SB(0, 1), cB + hstep, voffB); PG8_STAGE(PG8_SA(0, 0), cA, voffA); PG8_STAGE(PG8_SA(0, 1), cA + hstep, voffA);
        if (wr == 1) PG8_BAR;
        PG8_WAIT_V(2); PG8_BAR;
        PG8_STAGE(PG8_SB(1, 0), cB + kstep, voffB); PG8_STAGE(PG8_SA(1, 0), cA + kstep, voffA); PG8_STAGE(PG8_SB(1, 1), cB + hstep + kstep, voffB);
        PG8_WAIT_V(6); PG8_BAR;
    } else {
        PG8_STAGE(PG8_SB(0, 0), cB, voffB); PG8_STAGE(PG8_SA(0, 0), cA, voffA); PG8_STAGE(PG8_SB(0, 1), cB + hstep, voffB); PG8_STAGE(PG8_SA(0, 1), cA + hstep, voffA);
        if (wr == 1) PG8_BAR;
        PG8_WAIT_V(4); PG8_BAR;
        PG8_STAGE(PG8_SB(1, 0), cB + kstep, voffB); PG8_STAGE(PG8_SA(1, 0), cA + kstep, voffA); PG8_STAGE(PG8_SB(1, 1), cB + hstep + kstep, voffB);
        PG8_WAIT_V(6); PG8_BAR;
    }
    for (;;) {
        const bool has_next = S.next(ui + 1, nxt);
        const char* nA = has_next ? (const char*)g.A + (size_t)nxt.pm * tstep + (size_t)nxt.k0 * 2 : cA; const char* nB = has_next ? (const char*)g.Bt + (size_t)nxt.pn * tstep + (size_t)nxt.k0 * 2 : cB;
        const int nt = cur.nt;
        for (int t = 0; t < nt; t += 2) {
            const bool last = (t == nt - 2);
            const char* a1 = cA + (size_t)(t + 1) * kstep;
            const char* a2 = last ? nA : cA + (size_t)(t + 2) * kstep; const char* b2 = last ? nB : cB + (size_t)(t + 2) * kstep;
            const char* a3 = a2 + kstep; const char* b3 = b2 + kstep;
            if (last && has_next) S.a_ready(nxt);
            if constexpr (SP2) {
            PG8_LDB(B0, 0, 0); PG8_LDB(B1, 0, 1); PG8_SCHED; PG8_LDA(At, 0, 0); PG8_STAGE(PG8_SA(1, 1), a1 + hstep, voffA);
            PG8_WAIT_V(8); PG8_WAIT_L(0); PG8_BAR; PG8_MMA(0, 0, At, B0); PG8_MMA(0, 1, At, B1); PG8_BAR; PG8_SCHED;
            PG8_LDA(At, 0, 1); PG8_STAGE(PG8_SB(0, 0), b2, voffB); PG8_STAGE(PG8_SB(0, 1), b2 + hstep, voffB); PG8_STAGE(PG8_SA(0, 0), a2, voffA);
            PG8_WAIT_V(8); PG8_WAIT_L(0); PG8_BAR; PG8_MMA(1, 0, At, B0); PG8_MMA(1, 1, At, B1); PG8_BAR; PG8_SCHED;
            PG8_LDB(B0, 1, 0); PG8_LDB(B1, 1, 1); PG8_SCHED; PG8_LDA(At, 1, 0); PG8_STAGE(PG8_SA(0, 1), a2 + hstep, voffA);
            PG8_WAIT_V(8); PG8_WAIT_L(0); PG8_BAR; PG8_MMA(0, 0, At, B0); PG8_MMA(0, 1, At, B1); PG8_BAR; PG8_SCHED;
            PG8_LDA(At, 1, 1); PG8_STAGE(PG8_SB(1, 0), b3, voffB); PG8_STAGE(PG8_SB(1, 1), b3 + hstep, voffB); PG8_STAGE(PG8_SA(1, 0), a3, voffA);
            PG8_WAIT_V(8); PG8_WAIT_L(0); PG8_BAR; PG8_MMA(1, 0, At, B0); PG8_MMA(1, 1, At, B1); PG8_BAR; PG8_SCHED;
            } else {
            PG8_LDB(B0, 0, 0); PG8_SCHED; PG8_LDA(At, 0, 0); PG8_STAGE(PG8_SA(1, 1), a1 + hstep, voffA);
            PG8_WAIT_L(8); PG8_BAR; PG8_WAIT_L(0); PG8_MMA(0, 0, At, B0); PG8_BAR; PG8_SCHED;
            PG8_LDB(B1, 0, 1); PG8_STAGE(PG8_SB(0, 0), b2, voffB);
            PG8_BAR; PG8_WAIT_L(0); PG8_MMA(0, 1, At, B1); PG8_BAR;
            PG8_LDA(At, 0, 1); PG8_STAGE(PG8_SA(0, 0), a2, voffA);
            PG8_BAR; PG8_WAIT_L(0); PG8_MMA(1, 0, At, B0); PG8_BAR; PG8_SCHED;
            PG8_STAGE(PG8_SB(0, 1), b2 + hstep, voffB);
            PG8_WAIT_V(6); PG8_BAR; PG8_MMA(1, 1, At, B1); PG8_BAR;
            PG8_LDB(B0, 1, 0); PG8_SCHED; PG8_LDA(At, 1, 0); PG8_STAGE(PG8_SA(0, 1), a2 + hstep, voffA);
            PG8_WAIT_L(8); PG8_BAR; PG8_WAIT_L(0); PG8_MMA(0, 0, At, B0); PG8_BAR; PG8_SCHED;
            PG8_LDB(B1, 1, 1); PG8_STAGE(PG8_SB(1, 0), b3, voffB);
            PG8_BAR; PG8_WAIT_L(0); PG8_MMA(0, 1, At, B1); PG8_BAR;
            PG8_LDA(At, 1, 1); PG8_STAGE(PG8_SA(1, 0), a3, voffA);
            PG8_BAR; PG8_WAIT_L(0); PG8_MMA(1, 0, At, B0); PG8_BAR; PG8_SCHED;
            PG8_STAGE(PG8_SB(1, 1), b3 + hstep, voffB);
            PG8_WAIT_V(6); PG8_BAR; PG8_MMA(1, 1, At, B1); PG8_BAR;
            }
        }
        if constexpr (ALIGN_EPI) { if (wr == 0) PG8_BAR; }
        if constexpr (!Epi::AFTER_DRAIN) { E(acc, cur, wr, wc, fr, fq); S.done(cur); }
        if (!has_next) break;
#pragma unroll
        for (int a = 0; a < 2; ++a)
#pragma unroll
            for (int b = 0; b < 2; ++b)
#pragma unroll
                for (int m = 0; m < 4; ++m)
#pragma unroll
                    for (int n = 0; n < 2; ++n) acc[a][b][m][n] = (f32x4){0.f, 0.f, 0.f, 0.f};
        cur = nxt; cA = nA; cB = nB; ++ui;
        if constexpr (ALIGN_EPI) { if (wr == 1) PG8_BAR; }
    }
    PG8_WAIT_V(0);
    if constexpr (!ALIGN_EPI) { if (wr == 0) PG8_BAR; }
    PG8_BAR;
    if constexpr (Epi::AFTER_DRAIN) { E.fused(acc, cur, wr, wc, fr, fq, lds, wid, lane); S.done(cur); }
#undef PG8_SA
#undef PG8_SB
#undef PG8_STAGE
#undef PG8_LDA
#undef PG8_LDB
#undef PG8_MMA
#undef PG8_WAIT_V
#undef PG8_WAIT_L
#undef PG8_BAR
#undef PG8_SCHED
}
}

#ifndef ONE_LAUNCH
#define ONE_LAUNCH 1
#endif
namespace cg = cooperative_groups;
namespace pg8 {
#define LAS __attribute__((address_space(3)))
typedef float f32x16 __attribute__((ext_vector_type(16)));
typedef unsigned u32x2 __attribute__((ext_vector_type(2)));
constexpr int DM = 2048, TP = 4096, MP = 8192, MR = 8320, MT = 8448;
constexpr int RPROJ = 3360, PTOT = 7472, NIN = 7680, DFF = 8192;
constexpr int C_Q = 3360, C_K = 4384, C_V = 5408, C_F = 6432, C_OG = 6448;
constexpr int KL = 384, NL = 3072;
constexpr float ALPHA_RES = 1.189207115002721f;
constexpr float LOG2E = 1.4426950408889634f;
constexpr float QSCALE = 0.125f * 1.4426950408889634f;
constexpr size_t OFF_YS = 16777216, OFF_PK = 17039360, OFF_PV = 25427968, OFF_PLOGF = 33816576, OFF_PWKV = 33947648, OFF_PSHIFT = 34078720,
                 OFF_SK = 34085440, OFF_SV = 34216512, OFF_SLOGF = 34347584, OFF_SWKV = 34349632, OFF_SSHIFT = 34873920, OUT_TOTAL = 34900800;
constexpr size_t MiB = 1u << 20;
constexpr size_t WS_CTL = 0, WS_WIN = 1 * MiB, WS_LIN = 1 * MiB, WS_G = 8 * MiB, WS_KE = 25 * MiB, WS_WO = 31 * MiB, WS_WUP = 39 * MiB, WS_WDN = 71 * MiB, WS_LORA = 103 * MiB,
                 WS_XB = 106 * MiB, WS_YMIX = 106 * MiB, WS_PR = 139 * MiB, WS_HB = 139 * MiB, WS_Q = 194 * MiB, WS_KB = 210 * MiB + MiB / 2, WS_VT = 227 * MiB, WS_OG = 243 * MiB + MiB / 2,
                 WS_SLAB1 = 1 * MiB, WS_SLAB2 = 8 * MiB, WS_W = 260 * MiB, WS_ALR = 293 * MiB, WS_U = 172 * MiB, WS_END = 310 * MiB;
constexpr int LDS_BYTES = 147456, LDS_WORD_OFF = 140032, LDS_BARW_OFF = 140096, CW_BAR = 4096;
constexpr int NPH = 11;

struct Args { const float* in[28]; float* out; unsigned char* ws; int ph_lo, ph_hi, rep, pad; };

__device__ __forceinline__ unsigned f2bf(float f) { unsigned u = __builtin_bit_cast(unsigned, f); return (u + 0x7fffu + ((u >> 16) & 1u)) >> 16; }
__device__ __forceinline__ float bf2f(unsigned h) { return __builtin_bit_cast(float, h << 16); }
__device__ __forceinline__ float bflo(unsigned p) { return __builtin_bit_cast(float, p << 16); }
__device__ __forceinline__ float bfhi(unsigned p) { return __builtin_bit_cast(float, p & 0xffff0000u); }
__device__ __forceinline__ unsigned pk2(float lo, float hi) { return f2bf(lo) | (f2bf(hi) << 16); }
__device__ __forceinline__ float sigmoidf_(float x) { return 1.0f / (1.0f + __expf(-x)); }
#define LDS_WAIT() asm volatile("s_waitcnt lgkmcnt(0)" ::: "memory")

struct EpiIn {
    static constexpr bool PERM = true, AFTER_DRAIN = false;
    bf16_t *PR, *Q, *KB, *VT, *OG; float* out; const float* b_f;
    __device__ __forceinline__ void one(const f32x4 v0, const f32x4 v1, const int row, const int c0) const {
        if (c0 < C_Q) {
            u32x4 w; w.x = cvt_pk_bf16(v0[0], v0[1]); w.y = cvt_pk_bf16(v0[2], v0[3]); w.z = cvt_pk_bf16(v1[0], v1[1]); w.w = cvt_pk_bf16(v1[2], v1[3]);
            *(u32x4*)(PR + (size_t)row * RPROJ + c0) = w;
            if (row < MP) { if ((row & (TP - 1)) == TP - 1) { float* o = out + OFF_PSHIFT + (size_t)(row >> 12) * RPROJ + c0; *(f32x4*)o = v0; *(f32x4*)(o + 4) = v1; } }
            else { const int sr = row - MP; if ((sr & 15) == 15) { float* o = out + OFF_SSHIFT + (size_t)(sr >> 4) * RPROJ + c0; *(f32x4*)o = v0; *(f32x4*)(o + 4) = v1; } }
        } else if (c0 < C_K) {
            const f32x4 a = v0 * QSCALE, b = v1 * QSCALE;
            u32x4 w; w.x = cvt_pk_bf16(a[0], a[1]); w.y = cvt_pk_bf16(a[2], a[3]); w.z = cvt_pk_bf16(b[0], b[1]); w.w = cvt_pk_bf16(b[2], b[3]);
            *(u32x4*)(Q + (size_t)row * 1024 + (c0 - C_Q)) = w;
        } else if (c0 < C_V) {
            const int col = c0 - C_K;
            float* o = (row < MP) ? out + OFF_PK + (size_t)row * 1024 + col : out + OFF_SK + (size_t)(row - MP) * 1024 + col;
            *(f32x4*)o = v0; *(f32x4*)(o + 4) = v1;
            if (row < MP) { u32x4 w; w.x = cvt_pk_bf16(v0[0], v0[1]); w.y = cvt_pk_bf16(v0[2], v0[3]); w.z = cvt_pk_bf16(v1[0], v1[1]); w.w = cvt_pk_bf16(v1[2], v1[3]);
                *(u32x4*)(KB + (size_t)row * 1024 + col) = w; }
        } else if (c0 < C_F) {
            const int col = c0 - C_V;
            float* o = (row < MP) ? out + OFF_PV + (size_t)row * 1024 + col : out + OFF_SV + (size_t)(row - MP) * 1024 + col;
            *(f32x4*)o = v0; *(f32x4*)(o + 4) = v1;
            if (row < MP) {
                const int bb = row >> 12, t = row & (TP - 1), hh = col >> 6, d0 = col & 63;
                bf16_t* vt = VT + ((size_t)(bb * 16 + hh) * 64 + d0) * TP + t;
                const unsigned p0 = cvt_pk_bf16(v0[0], v0[1]), p1 = cvt_pk_bf16(v0[2], v0[3]), p2 = cvt_pk_bf16(v1[0], v1[1]), p3 = cvt_pk_bf16(v1[2], v1[3]);
                vt[0] = (bf16_t)(p0 & 0xffffu); vt[(size_t)1 * TP] = (bf16_t)(p0 >> 16); vt[(size_t)2 * TP] = (bf16_t)(p1 & 0xffffu); vt[(size_t)3 * TP] = (bf16_t)(p1 >> 16);
                vt[(size_t)4 * TP] = (bf16_t)(p2 & 0xffffu); vt[(size_t)5 * TP] = (bf16_t)(p2 >> 16); vt[(size_t)6 * TP] = (bf16_t)(p3 & 0xffffu); vt[(size_t)7 * TP] = (bf16_t)(p3 >> 16);
            }
        } else if (c0 < C_OG) {
            const int h0 = c0 - C_F;
            float* o = (row < MP) ? out + OFF_PLOGF + (size_t)row * 16 + h0 : out + OFF_SLOGF + (size_t)(row - MP) * 16 + h0;
            f32x4 r0, r1;
#pragma unroll
            for (int j = 0; j < 4; ++j) {
                const float x0 = v0[j] + b_f[h0 + j], x1 = v1[j] + b_f[h0 + 4 + j];
                r0[j] = fminf(x0, 0.f) - __logf(1.0f + __expf(-fabsf(x0))); r1[j] = fminf(x1, 0.f) - __logf(1.0f + __expf(-fabsf(x1)));
            }
            *(f32x4*)o = r0; *(f32x4*)(o + 4) = r1;
        } else if (c0 < PTOT) {
            f32x4 a, b;
#pragma unroll
            for (int j = 0; j < 4; ++j) { a[j] = sigmoidf_(v0[j]); b[j] = sigmoidf_(v1[j]); }
            u32x4 w; w.x = cvt_pk_bf16(a[0], a[1]); w.y = cvt_pk_bf16(a[2], a[3]); w.z = cvt_pk_bf16(b[0], b[1]); w.w = cvt_pk_bf16(b[2], b[3]);
            *(u32x4*)(OG + (size_t)row * 1024 + (c0 - C_OG)) = w;
        }
    }
    template <int I> __device__ __forceinline__ void rows(const f32x4 (&acc)[2][2][4][2], const int row0, const int cb) const {
        constexpr int ai = I >> 2, m = I & 3;
        const int row = row0 + ai * HALF + m * 16;
        if (row < MR) { one(acc[ai][0][m][0], acc[ai][0][m][1], row, cb); one(acc[ai][1][m][0], acc[ai][1][m][1], row, cb + HALF); }
    }
    __device__ __forceinline__ void operator()(const f32x4 (&acc)[2][2][4][2], const Unit& u, int wr, int wc, int fr, int fq) const {
        const int row0 = u.pm * BM + wr * 64 + fr;
        const int cb = u.pn * BM + wc * 32 + 8 * fq;
        rows<0>(acc, row0, cb); rows<1>(acc, row0, cb); rows<2>(acc, row0, cb); rows<3>(acc, row0, cb);
        rows<4>(acc, row0, cb); rows<5>(acc, row0, cb); rows<6>(acc, row0, cb); rows<7>(acc, row0, cb);
    }
};

struct EpiLora {
    static constexpr bool PERM = true, AFTER_DRAIN = false;
    float* W; bf16_t *ALR, *G; const float *w0, *a0;
    template <int REG> __device__ __forceinline__ void one(const f32x4 x0, const f32x4 x1, const int row, const int c0) const {
        if (REG == 0) {
            const f32x4 v0 = x0 + *(const f32x4*)(w0 + c0), v1 = x1 + *(const f32x4*)(w0 + c0 + 4);
            f32x4 r0, r1;
#pragma unroll
            for (int j = 0; j < 4; ++j) {
                const float p0 = v0[j], p1 = v1[j];
                const float l0 = fminf(p0, 0.f) - __logf(1.0f + __expf(-fabsf(p0))) - 0.5f, l1 = fminf(p1, 0.f) - __logf(1.0f + __expf(-fabsf(p1))) - 0.5f;
                r0[j] = __expf(-__expf(l0)); r1[j] = __expf(-__expf(l1));
            }
            float* o = W + (size_t)row * 1024 + c0; *(f32x4*)o = r0; *(f32x4*)(o + 4) = r1;
        } else if (REG == 1) {
            const f32x4 v0 = x0 + *(const f32x4*)(a0 + c0 - 1024), v1 = x1 + *(const f32x4*)(a0 + c0 - 1020);
            f32x4 a, b;
#pragma unroll
            for (int j = 0; j < 4; ++j) { a[j] = sigmoidf_(v0[j]); b[j] = sigmoidf_(v1[j]); }
            u32x4 w; w.x = cvt_pk_bf16(a[0], a[1]); w.y = cvt_pk_bf16(a[2], a[3]); w.z = cvt_pk_bf16(b[0], b[1]); w.w = cvt_pk_bf16(b[2], b[3]);
            *(u32x4*)(ALR + (size_t)row * 1024 + (c0 - 1024)) = w;
        } else {
            u32x4 w; w.x = cvt_pk_bf16(x0[0], x0[1]); w.y = cvt_pk_bf16(x0[2], x0[3]); w.z = cvt_pk_bf16(x1[0], x1[1]); w.w = cvt_pk_bf16(x1[2], x1[3]);
            *(u32x4*)(G + (size_t)row * 1024 + (c0 - 2048)) = w;
        }
    }
    template <int I, int REG> __device__ __forceinline__ void rows(const f32x4 (&acc)[2][2][4][2], const int row0, const int cb) const {
        constexpr int ai = I >> 2, m = I & 3;
        const int row = row0 + ai * HALF + m * 16;
        if (row < MR) { one<REG>(acc[ai][0][m][0], acc[ai][0][m][1], row, cb); one<REG>(acc[ai][1][m][0], acc[ai][1][m][1], row, cb + HALF); }
    }
    template <int REG> __device__ __forceinline__ void all(const f32x4 (&acc)[2][2][4][2], const int row0, const int cb) const {
        rows<0, REG>(acc, row0, cb); rows<1, REG>(acc, row0, cb); rows<2, REG>(acc, row0, cb); rows<3, REG>(acc, row0, cb);
        rows<4, REG>(acc, row0, cb); rows<5, REG>(acc, row0, cb); rows<6, REG>(acc, row0, cb); rows<7, REG>(acc, row0, cb);
    }
    __device__ __forceinline__ void operator()(const f32x4 (&acc)[2][2][4][2], const Unit& u, int wr, int wc, int fr, int fq) const {
        const int row0 = u.pm * BM + wr * 64 + fr;
        const int cb = u.pn * BM + wc * 32 + 8 * fq;
        const int reg = __builtin_amdgcn_readfirstlane(u.pn >> 2);
        if (reg == 0) all<0>(acc, row0, cb); else if (reg == 1) all<1>(acc, row0, cb); else all<2>(acc, row0, cb);
    }
};

struct EpiRes {
    static constexpr bool PERM = true, AFTER_DRAIN = false;
    const float* basep; const bf16_t* baseh; float* Z; float* slab; int KC;
    __device__ __forceinline__ void operator()(const f32x4 (&acc)[2][2][4][2], const Unit& u, int wr, int wc, int fr, int fq) const {
        if (u.smp) {
            float* sp = slab + (size_t)(u.k0 / KC) * (128 * DM) + (size_t)(wr * 64 + fr) * DM + u.pn * BM + wc * 32 + 8 * fq;
#pragma unroll
            for (int m = 0; m < 4; ++m)
#pragma unroll
                for (int bj = 0; bj < 2; ++bj) { *(f32x4*)(sp + (size_t)m * 16 * DM + bj * HALF) = acc[0][bj][m][0]; *(f32x4*)(sp + (size_t)m * 16 * DM + bj * HALF + 4) = acc[0][bj][m][1]; }
            return;
        }
        const int row0 = u.pm * BM + wr * 64 + fr;
#pragma unroll
        for (int ai = 0; ai < 2; ++ai)
#pragma unroll
            for (int m = 0; m < 4; ++m) {
                const int row = row0 + ai * HALF + m * 16;
                const float* bp = basep + (size_t)row * DM;
                float* zp = Z + (size_t)row * DM;
#pragma unroll
                for (int bj = 0; bj < 2; ++bj) {
                    const int c0 = u.pn * BM + bj * HALF + wc * 32 + 8 * fq;
                    f32x4 x0, x1;
                    if (basep) { x0 = *(const f32x4*)(bp + c0); x1 = *(const f32x4*)(bp + c0 + 4); }
                    else { const u32x4 hb = *(const u32x4*)(baseh + (size_t)row * DM + c0); x0 = (f32x4){bflo(hb.x), bfhi(hb.x), bflo(hb.y), bfhi(hb.y)}; x1 = (f32x4){bflo(hb.z), bfhi(hb.z), bflo(hb.w), bfhi(hb.w)}; }
                    *(f32x4*)(zp + c0) = x0 * ALPHA_RES + acc[ai][bj][m][0]; *(f32x4*)(zp + c0 + 4) = x1 * ALPHA_RES + acc[ai][bj][m][1];
                }
            }
    }
};

struct EpiUp {
    static constexpr bool PERM = true, AFTER_DRAIN = false;
    bf16_t* U;
    __device__ __forceinline__ void operator()(const f32x4 (&acc)[2][2][4][2], const Unit& u, int wr, int wc, int fr, int fq) const {
        const int row0 = u.pm * BM + wr * 64 + fr;
#pragma unroll
        for (int ai = 0; ai < 2; ++ai)
#pragma unroll
            for (int m = 0; m < 4; ++m) {
                bf16_t* rowp = U + (size_t)(row0 + ai * HALF + m * 16) * DFF + u.pn * BM + wc * 32 + 8 * fq;
#pragma unroll
                for (int bj = 0; bj < 2; ++bj) {
                    f32x4 v0 = acc[ai][bj][m][0], v1 = acc[ai][bj][m][1];
#pragma unroll
                    for (int j = 0; j < 4; ++j) { const float a = fmaxf(v0[j], 0.f), b = fmaxf(v1[j], 0.f); v0[j] = a * a; v1[j] = b * b; }
                    u32x4 w; w.x = cvt_pk_bf16(v0[0], v0[1]); w.y = cvt_pk_bf16(v0[2], v0[3]); w.z = cvt_pk_bf16(v1[0], v1[1]); w.w = cvt_pk_bf16(v1[2], v1[3]);
                    *(u32x4*)(rowp + bj * HALF) = w;
                }
            }
    }
};

__device__ __forceinline__ float wave_sum(float v) {
#pragma unroll
    for (int o = 1; o < 64; o <<= 1) v += __shfl_xor(v, o);
    return v;
}
__device__ __forceinline__ float wave_max(float v) {
#pragma unroll
    for (int o = 1; o < 64; o <<= 1) v = fmaxf(v, __shfl_xor(v, o));
    return v;
}
__device__ __forceinline__ float red32(float v) {
#pragma unroll
    for (int o = 1; o < 32; o <<= 1) v += __shfl_xor(v, o);
    return v;
}
template <int CTRL> __device__ __forceinline__ float dpp_add(float x) {
    return x + __builtin_bit_cast(float, __builtin_amdgcn_update_dpp(0, __builtin_bit_cast(int, x), CTRL, 0xf, 0xf, false));
}
__device__ __forceinline__ float row16_sum(float x) {
    x = dpp_add<0xB1>(x); x = dpp_add<0x4E>(x); x = dpp_add<0x141>(x); x = dpp_add<0x140>(x); return x;
}

__device__ __forceinline__ void p0_transpose_item(const float* __restrict__ W, int K, int N, bf16_t* __restrict__ WT, LAS float* scr, int item, int lane) {
    const int nblk = (N + 31) >> 5, kb = item / nblk, nb = item - kb * nblk, k0 = 64 * kb, n0 = 32 * nb;
    const int kr = lane >> 3, n4 = (lane & 7) * 4; const bool ok = (n0 + n4) < N;
    f32x4 v[8];
#pragma unroll
    for (int i = 0; i < 8; ++i) v[i] = ok ? *(const f32x4*)(W + (size_t)(k0 + kr + 8 * i) * N + n0 + n4) : (f32x4){0.f, 0.f, 0.f, 0.f};
#pragma unroll
    for (int i = 0; i < 8; ++i) { LAS float* d = scr + (kr + 8 * i) * 33 + n4; d[0] = v[i][0]; d[1] = v[i][1]; d[2] = v[i][2]; d[3] = v[i][3]; }
    LDS_WAIT();
    const int c = lane & 7;
#pragma unroll
    for (int j = 0; j < 4; ++j) { const int n = (lane >> 3) + 8 * j; const LAS float* s = scr + (8 * c) * 33 + n;
        u32x4 o; o.x = pk2(s[0 * 33], s[1 * 33]); o.y = pk2(s[2 * 33], s[3 * 33]); o.z = pk2(s[4 * 33], s[5 * 33]); o.w = pk2(s[6 * 33], s[7 * 33]);
        *(u32x4*)(WT + (size_t)(n0 + n) * K + k0 + 8 * c) = o; }
    LDS_WAIT();
}
constexpr int I_IN = (DM / 64) * ((PTOT + 31) / 32), I_O = (DM / 64) * (DM / 32), I_UP = (DM / 64) * (DFF / 32), I_DN = (DFF / 64) * (DM / 32);
__device__ __forceinline__ void late_transpose_item(const Args& a, LAS float* scr, int r, int lane) {
    unsigned char* ws = a.ws;
    if (r < I_O) { p0_transpose_item(a.in[21], DM, DM, (bf16_t*)(ws + WS_WO), scr, r, lane); return; } r -= I_O;
    if (r < I_UP) { p0_transpose_item(a.in[24], DM, DFF, (bf16_t*)(ws + WS_WUP), scr, r, lane); return; } r -= I_UP;
    if (r < I_DN) p0_transpose_item(a.in[25], DFF, DM, (bf16_t*)(ws + WS_WDN), scr, r, lane);
}

__device__ __forceinline__ void late_item_desc(const Args& a, int r, const float*& W, bf16_t*& WT, int& K, int& N, int& ri) {
    unsigned char* ws = a.ws;
    if (r < I_O) { W = a.in[21]; WT = (bf16_t*)(ws + WS_WO); K = DM; N = DM; ri = r; }
    else if (r < I_O + I_UP) { W = a.in[24]; WT = (bf16_t*)(ws + WS_WUP); K = DM; N = DFF; ri = r - I_O; }
    else { W = a.in[25]; WT = (bf16_t*)(ws + WS_WDN); K = DFF; N = DM; ri = r - I_O - I_UP; }
}
__device__ __forceinline__ void late_item_load(const Args& a, int r, int lane, f32x4 (&v)[8]) {
    const float* W; bf16_t* WT; int K, N, ri; late_item_desc(a, r, W, WT, K, N, ri);
    const int nblk = N >> 5, kb = ri / nblk, nb = ri - kb * nblk, k0 = 64 * kb, n0 = 32 * nb, kr = lane >> 3, n4 = (lane & 7) * 4;
#pragma unroll
    for (int i = 0; i < 8; ++i) v[i] = *(const f32x4*)(W + (size_t)(k0 + kr + 8 * i) * N + n0 + n4);
}
__device__ __forceinline__ void late_item_finish(const Args& a, int r, int lane, const f32x4 (&v)[8], LAS float* scr) {
    const float* W; bf16_t* WT; int K, N, ri; late_item_desc(a, r, W, WT, K, N, ri);
    const int nblk = N >> 5, kb = ri / nblk, nb = ri - kb * nblk, k0 = 64 * kb, n0 = 32 * nb, kr = lane >> 3, n4 = (lane & 7) * 4;
#pragma unroll
    for (int i = 0; i < 8; ++i) { LAS float* d = scr + (kr + 8 * i) * 33 + n4; d[0] = v[i][0]; d[1] = v[i][1]; d[2] = v[i][2]; d[3] = v[i][3]; }
    LDS_WAIT();
    const int c = lane & 7;
#pragma unroll
    for (int j = 0; j < 4; ++j) { const int n = (lane >> 3) + 8 * j; const LAS float* s = scr + (8 * c) * 33 + n;
        u32x4 o; o.x = pk2(s[0 * 33], s[1 * 33]); o.y = pk2(s[2 * 33], s[3 * 33]); o.z = pk2(s[4 * 33], s[5 * 33]); o.w = pk2(s[6 * 33], s[7 * 33]);
        *(u32x4*)(WT + (size_t)(n0 + n) * K + k0 + 8 * c) = o; }
    LDS_WAIT();
}

__device__ __forceinline__ void phase0(const Args& a, LAS unsigned char* lds) {
    const int tid = threadIdx.x, lane = tid & 63, wave = tid >> 6, G = gridDim.x;
    unsigned char* ws = a.ws;
    if (blockIdx.x == 0 && tid < 256) ((unsigned*)(ws + WS_CTL))[tid] = 0u;
    LAS float* scr = (LAS float*)(lds + wave * 16384);
    const int gw = blockIdx.x * 8 + wave, NGW = G * 8;
    for (int it = gw; it < I_IN; it += NGW) p0_transpose_item(a.in[7], DM, PTOT, (bf16_t*)(ws + WS_WIN), scr, it, lane);
    const int gt = blockIdx.x * 512 + tid, NT = G * 512;
    { bf16_t* XB = (bf16_t*)(ws + WS_XB);
      for (int i = gt; i < MT * 256; i += NT) { const int row = i >> 8, c8 = (i & 255) * 8;
          u32x4 o = (u32x4){0u, 0u, 0u, 0u};
          if (row < MR) { const float* src = (row < MP) ? a.in[0] + (size_t)row * DM + c8 : a.in[1] + (size_t)(row - MP) * DM + c8;
              const f32x4 x0 = *(const f32x4*)src, x1 = *(const f32x4*)(src + 4);
              o.x = pk2(x0[0], x0[1]); o.y = pk2(x0[2], x0[3]); o.z = pk2(x1[0], x1[1]); o.w = pk2(x1[2], x1[3]); }
          *(u32x4*)(XB + (size_t)row * DM + c8) = o; } }
    { bf16_t* LT = (bf16_t*)(ws + WS_LORA);
      const float* w2 = a.in[10]; const float* a2 = a.in[12]; const float* g2 = a.in[13];
      for (int i = gt; i < NL * KL; i += NT) { const int n = i / KL, c = i - n * KL; float v = 0.f;
          if (n < 1024) { if (c < 64) v = w2[c * 1024 + n]; }
          else if (n < 2048) { if (c >= 64 && c < 128) v = a2[(c - 64) * 1024 + (n - 1024)]; }
          else { if (c >= 128 && c < 288) v = g2[(c - 128) * 1024 + (n - 2048)]; }
          LT[i] = (bf16_t)f2bf(v); } }
}

__device__ __forceinline__ void phase2(const Args& a) {
    const int tid = threadIdx.x, lane = tid & 63, wave = tid >> 6, G = gridDim.x;
    unsigned char* ws = a.ws;
    const bf16_t* PR = (const bf16_t*)(ws + WS_PR); bf16_t* LIN = (bf16_t*)(ws + WS_LIN);
    const float* mu = a.in[8]; const float* sshift = a.in[6];
    const int gt = blockIdx.x * 512 + tid, NT = G * 512;
    for (int i = gt; i < MT * (KL / 2); i += NT) {
        const int row = i / (KL / 2), j = (i - row * (KL / 2)) * 2;
        unsigned o = 0u;
        if (row < MR && j < 288) {
            const int col = 3072 + j;
            const unsigned pc = *(const unsigned*)(PR + (size_t)row * RPROJ + col);
            const float p0 = bflo(pc), p1 = bfhi(pc);
            float q0 = 0.f, q1 = 0.f;
            const int t = (row < MP) ? (row & (TP - 1)) : ((row - MP) & 15);
            if (t > 0) { const unsigned pp = *(const unsigned*)(PR + (size_t)(row - 1) * RPROJ + col); q0 = bflo(pp); q1 = bfhi(pp); }
            else if (row >= MP) { const float* s = sshift + (size_t)((row - MP) >> 4) * RPROJ + col; q0 = s[0]; q1 = s[1]; }
            const float x0 = p0 + (q0 - p0) * mu[col], x1 = p1 + (q1 - p1) * mu[col + 1];
            float f0, f1;
            if (j < 64) { f0 = tanhf(x0); f1 = tanhf(x1); } else if (j < 128) { f0 = x0; f1 = x1; } else { f0 = sigmoidf_(x0); f1 = sigmoidf_(x1); }
            o = pk2(f0, f1);
        }
        *(unsigned*)(LIN + (size_t)row * KL + j) = o;
    }
    const int gw = blockIdx.x * 8 + wave;
    if (gw < 32) {
        const int b = gw >> 4, h = gw & 15, t0 = lane * 64;
        const float* lf = a.out + OFF_PLOGF + ((size_t)b * TP + t0) * 16 + h;
        float loc = 0.f;
        for (int i = 0; i < 64; ++i) loc += lf[i * 16];
        float inc = loc;
#pragma unroll
        for (int o = 1; o < 64; o <<= 1) { const float n = __shfl_up(inc, o); if (lane >= o) inc += n; }
        float run = inc - loc;
        bf16_t* KE = (bf16_t*)(ws + WS_KE) + ((size_t)gw * TP + t0) * 4;
        for (int i = 0; i < 64; ++i) {
            run += lf[i * 16];
            const float kb = -run * LOG2E;
            const unsigned hi = f2bf(kb); const float r1 = kb - bf2f(hi);
            const unsigned mid = f2bf(r1); const float r2 = r1 - bf2f(mid);
            const unsigned lo = f2bf(r2);
            u32x2 o; o.x = hi | (mid << 16); o.y = lo;
            *(u32x2*)(KE + i * 4) = o;
        }
    }
}

__device__ __forceinline__ void ln_phase(float* Z, const float* g, const float* bta, bf16_t* HB, const float* sbase, const float* slab, const int nslab) {
    const int tid = threadIdx.x, lane = tid & 63, wave = tid >> 6;
    const int gw = blockIdx.x * 8 + wave, NGW = gridDim.x * 8;
    for (int it = gw; it < MT; it += NGW) {
        const int row = (it < 128) ? MP + it : (it < MR ? it - 128 : it);
        if (row >= MR) { if (HB) { u32x4* o = (u32x4*)(HB + (size_t)row * DM); for (int j = 0; j < 4; ++j) o[64 * j + lane] = (u32x4){0u, 0u, 0u, 0u}; } continue; }
        f32x4* zr = (f32x4*)(Z + (size_t)row * DM);
        f32x4 v[8]; float s = 0.f;
        if (row < MP) {
#pragma unroll
            for (int j = 0; j < 8; ++j) v[j] = zr[64 * j + lane];
        } else {
            const f32x4* br = (const f32x4*)(sbase + (size_t)(row - MP) * DM);
#pragma unroll
            for (int j = 0; j < 8; ++j) v[j] = br[64 * j + lane] * ALPHA_RES;
            for (int k = 0; k < nslab; ++k) { const f32x4* sr = (const f32x4*)(slab + ((size_t)k * 128 + (row - MP)) * DM);
#pragma unroll
                for (int j = 0; j < 8; ++j) v[j] += sr[64 * j + lane]; }
        }
#pragma unroll
        for (int j = 0; j < 8; ++j) s += (v[j][0] + v[j][1]) + (v[j][2] + v[j][3]);
        const float mean = wave_sum(s) * (1.f / DM); float s2 = 0.f;
#pragma unroll
        for (int j = 0; j < 8; ++j) { v[j] = v[j] - mean; s2 += (v[j][0] * v[j][0] + v[j][1] * v[j][1]) + (v[j][2] * v[j][2] + v[j][3] * v[j][3]); }
        const float rstd = rsqrtf(wave_sum(s2) * (1.f / DM) + 1e-5f);
#pragma unroll
        for (int j = 0; j < 8; ++j) {
            const f32x4 gg = ((const f32x4*)g)[64 * j + lane], bb = ((const f32x4*)bta)[64 * j + lane];
            const f32x4 y = v[j] * rstd * gg + bb;
            if (!HB || row >= MP) zr[64 * j + lane] = y;
            if (HB) { u32x2 o; o.x = pk2(y[0], y[1]); o.y = pk2(y[2], y[3]); *(u32x2*)(HB + (size_t)row * DM + (64 * j + lane) * 4) = o; }
        }
    }
}

__device__ __forceinline__ float row32_sum(float x) {
    x = row16_sum(x);
    float xa = x, xb = x;
    asm volatile("s_nop 1\n\tv_permlane32_swap_b32 %0, %1" : "+v"(xa), "+v"(xb));
    return xa + xb;
}
__device__ __forceinline__ float half32_sum(float x) {
    x = row16_sum(x);
    return x + __shfl_xor(x, 16);
}
template <bool SAMPLE>
__device__ __forceinline__ void scan_unit(const Args& a, unsigned char* lds, int b, int h, int qt, int sbi) {
    constexpr int TC = SAMPLE ? 16 : 32, NCH = SAMPLE ? 1 : (TP / 32), NS = TC / 8;
    const int tid = threadIdx.x, lane = tid & 63, w = __builtin_amdgcn_readfirstlane(tid >> 6);
    const size_t rowbase = SAMPLE ? (size_t)(MP + b * 16) : (size_t)b * TP;
    unsigned char* ws = a.ws;
    float* buf = (float*)lds;
    if (w < 4) {
        const int s = lane & 15, row = qt * 16 + w * 4 + (lane >> 4);
        bf16_t* YM = (bf16_t*)(ws + WS_YMIX) + rowbase * DM + h * 64 + row;
        typedef float f32x2 __attribute__((ext_vector_type(2)));
        f32x2 S01 = (f32x2){0.f, 0.f}, S23 = (f32x2){0.f, 0.f};
        if (SAMPLE) { const f32x4 x = *(const f32x4*)(a.in[5] + ((size_t)(b * 16 + h) * 64 + row) * 64 + 4 * s); S01 = x.lo; S23 = x.hi; }
        __syncthreads();
        for (int n = 0; n < NCH; ++n) {
            const float* bb = buf + (n & 1) * (TC * 384);
#pragma unroll 1
            for (int hf = 0; hf < TC / 16; ++hf) {
                float yk = 0.f;
#pragma unroll 8
                for (int st = 0; st < 16; ++st) {
                    const float* p = bb + (hf * 16 + st) * 384;
                    const f32x4 w4 = *(const f32x4*)(p + 4 * s), kh4 = *(const f32x4*)(p + 64 + 4 * s), a4 = *(const f32x4*)(p + 128 + 4 * s), b4 = *(const f32x4*)(p + 192 + 4 * s), r4 = *(const f32x4*)(p + 256 + 4 * s);
                    const float v = p[320 + row];
                    const f32x2 vv = (f32x2){v, v};
                    const f32x2 pv = S01 * a4.lo + S23 * a4.hi;
                    const f32x2 u01 = S01 * w4.lo + vv * kh4.lo, u23 = S23 * w4.hi + vv * kh4.hi;
                    const float sa = row16_sum(pv.x + pv.y);
                    const f32x2 sv = (f32x2){sa, sa};
                    S01 = sv * b4.lo + u01; S23 = sv * b4.hi + u23;
                    const f32x2 qv = S01 * r4.lo + S23 * r4.hi;
                    const float y = row16_sum(qv.x + qv.y);
                    yk = (s == st) ? y : yk;
                }
                YM[((size_t)n * TC + hf * 16 + s) * DM] = (bf16_t)f2bf(yk);
            }
            __syncthreads();
        }
        *(f32x4*)(a.out + (SAMPLE ? OFF_SWKV : OFF_PWKV) + ((size_t)(b * 16 + h) * 64 + row) * 64 + 4 * s) = (f32x4){S01.x, S01.y, S23.x, S23.y};
    } else {
        const bf16_t* PR = (const bf16_t*)(ws + WS_PR); const float* Wd = (const float*)(ws + WS_W); const bf16_t* ALR = (const bf16_t*)(ws + WS_ALR);
        const int ptid = tid - 256, pst = ptid >> 5, cp = ptid & 31, ch = h * 64 + 2 * cp;
        const float mur0 = a.in[8][ch], mur1 = a.in[8][ch + 1], muk0 = a.in[8][1024 + ch], muk1 = a.in[8][1025 + ch], muv0 = a.in[8][2048 + ch], muv1 = a.in[8][2049 + ch];
        const float kk0 = a.in[14][ch], kk1 = a.in[14][ch + 1], ka0 = a.in[15][ch], ka1 = a.in[15][ch + 1], rk0 = a.in[16][ch], rk1 = a.in[16][ch + 1];
        bf16_t* BV = (bf16_t*)a.out;
        unsigned rc[NS], kc[NS], vc[NS], rp[NS], kp[NS], vp[NS], al[NS]; float w0[NS], w1[NS];
#define SCAN_LOAD(n) do { _Pragma("unroll") for (int i_ = 0; i_ < NS; ++i_) { const int st_ = pst + 8 * i_; const size_t row_ = rowbase + (size_t)(n) * TC + st_; const bf16_t* pr_ = PR + row_ * RPROJ + ch; \
        rc[i_] = *(const unsigned*)pr_; kc[i_] = *(const unsigned*)(pr_ + 1024); vc[i_] = *(const unsigned*)(pr_ + 2048); \
        if ((n) > 0 || st_ > 0) { rp[i_] = *(const unsigned*)(pr_ - RPROJ); kp[i_] = *(const unsigned*)(pr_ - RPROJ + 1024); vp[i_] = *(const unsigned*)(pr_ - RPROJ + 2048); } else { rp[i_] = 0u; kp[i_] = 0u; vp[i_] = 0u; } \
        { const float* wp_ = Wd + row_ * 1024 + ch; w0[i_] = wp_[0]; w1[i_] = wp_[1]; } al[i_] = *(const unsigned*)(ALR + row_ * 1024 + ch); } } while (0)
#define SCAN_PREP(n) do { _Pragma("unroll") for (int i_ = 0; i_ < NS; ++i_) { const int st_ = pst + 8 * i_; float* bb_ = buf + ((n) & 1) * (TC * 384) + st_ * 384; \
        const float r0_ = bflo(rc[i_]), r1_ = bfhi(rc[i_]), k0_ = bflo(kc[i_]), k1_ = bfhi(kc[i_]), v0_ = bflo(vc[i_]), v1_ = bfhi(vc[i_]); \
        float rq0 = bflo(rp[i_]), rq1 = bfhi(rp[i_]), kq0 = bflo(kp[i_]), kq1 = bfhi(kp[i_]), vq0 = bflo(vp[i_]), vq1 = bfhi(vp[i_]); \
        if (SAMPLE && (n) == 0 && st_ == 0) { const float* sh_ = a.in[6] + (size_t)b * RPROJ + ch; rq0 = sh_[0]; rq1 = sh_[1]; kq0 = sh_[1024]; kq1 = sh_[1025]; vq0 = sh_[2048]; vq1 = sh_[2049]; } \
        const float rs0 = r0_ + (rq0 - r0_) * mur0, rs1 = r1_ + (rq1 - r1_) * mur1, ks0 = k0_ + (kq0 - k0_) * muk0, ks1 = k1_ + (kq1 - k1_) * muk1; \
        const float vs0 = v0_ + (vq0 - v0_) * muv0, vs1 = v1_ + (vq1 - v1_) * muv1; \
        const float n0_ = ks0 * kk0, n1_ = ks1 * kk1; const float ss_ = half32_sum(n0_ * n0_ + n1_ * n1_); const float inv_ = 1.0f / fmaxf(sqrtf(ss_), 1e-12f); \
        const float kn0 = n0_ * inv_, kn1 = n1_ * inv_, al0 = bflo(al[i_]), al1 = bfhi(al[i_]); \
        const float kh0 = ks0 * (1.0f + (al0 - 1.0f) * ka0), kh1 = ks1 * (1.0f + (al1 - 1.0f) * ka1); \
        { const float bo_ = half32_sum(rs0 * kh0 * rk0 + rs1 * kh1 * rk1); if ((cp >> 3) == qt) *(unsigned*)(BV + (rowbase + (size_t)(n) * TC + st_) * 1024 + ch) = pk2(bo_ * vs0, bo_ * vs1); } \
        *(float2*)(bb_ + 2 * cp) = make_float2(w0[i_], w1[i_]); *(float2*)(bb_ + 64 + 2 * cp) = make_float2(kh0, kh1); *(float2*)(bb_ + 128 + 2 * cp) = make_float2(-kn0, -kn1); \
        *(float2*)(bb_ + 192 + 2 * cp) = make_float2(kn0 * al0, kn1 * al1); *(float2*)(bb_ + 256 + 2 * cp) = make_float2(rs0, rs1); *(float2*)(bb_ + 320 + 2 * cp) = make_float2(vs0, vs1); } } while (0)
        SCAN_LOAD(0); SCAN_PREP(0);
        if (NCH > 1) SCAN_LOAD(1);
        LAS float* tscr = (LAS float*)((LAS unsigned char*)lds + 98304 + (w - 4) * 8448);
        f32x4 tv[8]; int tit = -1; const int pw = sbi * 4 + (w - 4);
        __syncthreads();
        for (int n = 0; n < NCH; ++n) {
            if (!SAMPLE && tit >= 0) late_item_finish(a, tit, lane, tv, tscr);
            if (n + 1 < NCH) { SCAN_PREP(n + 1); if (n + 2 < NCH) SCAN_LOAD(n + 2); }
            if (!SAMPLE) { tit = pw + 512 * n; if (tit < I_O + I_UP + I_DN) late_item_load(a, tit, lane, tv); else tit = -1; }
            __syncthreads();
        }
        if (!SAMPLE && tit >= 0) late_item_finish(a, tit, lane, tv, tscr);
#undef SCAN_LOAD
#undef SCAN_PREP
    }
}

__device__ __forceinline__ void phase_gn(const Args& a) {
    const int tid = threadIdx.x, lane = tid & 63, wave = tid >> 6;
    const int gw = blockIdx.x * 8 + wave, NGW = gridDim.x * 8;
    unsigned char* ws = a.ws;
    const bf16_t* Gt = (const bf16_t*)(ws + WS_G); bf16_t* YM = (bf16_t*)(ws + WS_YMIX); const bf16_t* BV = (const bf16_t*)a.out;
    for (int item = gw; item < MR * 16; item += NGW) {
        const int row = item >> 4, h = item & 15, ch = h * 64 + lane;
        const float y = bf2f(YM[(size_t)row * DM + ch]);
        const float bv = bf2f(BV[(size_t)row * 1024 + ch]), g = bf2f(Gt[(size_t)row * 1024 + ch]);
        const float mean = wave_sum(y) * (1.f / 64.f); const float d = y - mean;
        const float var = wave_sum(d * d) * (1.f / 64.f); const float rstd = rsqrtf(var + 64e-5f);
        const float o = (d * rstd * a.in[17][ch] + a.in[18][ch] + bv) * g;
        YM[(size_t)row * DM + ch] = (bf16_t)f2bf(o);
    }
}

__device__ __forceinline__ int crow(int r, int hi) { return (r & 3) + 8 * (r >> 2) + 4 * hi; }
__device__ __forceinline__ void attn_unit(const Args& a, unsigned char* lds, int bh, int qb) {
    const int tid = threadIdx.x, lane = tid & 63, w = tid >> 6, r32 = lane & 31, hi = lane >> 5;
    const int b = bh >> 4, h = bh & 15;
    unsigned char* ws = a.ws;
    const bf16_t* Q = (const bf16_t*)(ws + WS_Q); const bf16_t* KB = (const bf16_t*)(ws + WS_KB); const bf16_t* VT = (const bf16_t*)(ws + WS_VT);
    const bf16_t* KE = (const bf16_t*)(ws + WS_KE); const bf16_t* OG = (const bf16_t*)(ws + WS_OG); bf16_t* YM = (bf16_t*)(ws + WS_YMIX);
    bf16_t* Kt = (bf16_t*)lds;
    bf16_t* Vt = (bf16_t*)(lds + 18432);
    bf16_t* Et = (bf16_t*)(lds + 18432 + 17408);
    const size_t tokbase = (size_t)b * TP;
    const int q0 = qb * 256 + w * 32;
    bf16x8 qf[4];
    { const bf16_t* qp = Q + (tokbase + q0 + r32) * 1024 + h * 64 + hi * 8;
#pragma unroll
      for (int s = 0; s < 4; ++s) qf[s] = *(const bf16x8*)(qp + 16 * s); }
    bf16x8 qx = (bf16x8){0, 0, 0, 0, 0, 0, 0, 0};
    if (hi == 0) { qx[0] = (short)0x3F80; qx[1] = (short)0x3F80; qx[2] = (short)0x3F80; }
    f32x16 ot0, ot1;
#pragma unroll
    for (int r = 0; r < 16; ++r) { ot0[r] = 0.f; ot1[r] = 0.f; }
    float mrun = -INFINITY, lrun = 0.f;
    const int NT = 4 * (qb + 1);
    const int srow = tid >> 3, sch = tid & 7;
    const bf16_t* kg = KB + (tokbase + srow) * 1024 + h * 64 + sch * 8;
    const bf16_t* vg = VT + ((size_t)bh * 64 + srow) * TP + sch * 8;
    const bf16_t* eg = KE + ((size_t)bh * TP + (tid & 63)) * 4;
    u32x4 kreg, vreg; u32x2 ereg = (u32x2){0u, 0u};
#define ATT_LOAD(t) do { kreg = *(const u32x4*)(kg + (size_t)(t) * 64 * 1024); vreg = *(const u32x4*)(vg + (t) * 64); if (tid < 64) ereg = *(const u32x2*)(eg + (t) * 64 * 4); } while (0)
#define ATT_WRITE(bufi) do { *(u32x4*)(Kt + (bufi) * 4608 + srow * 72 + sch * 8) = kreg; \
        *(u32x2*)(Vt + (bufi) * 4352 + srow * 68 + sch * 8) = (u32x2){vreg.x, vreg.y}; *(u32x2*)(Vt + (bufi) * 4352 + srow * 68 + sch * 8 + 4) = (u32x2){vreg.z, vreg.w}; \
        if (tid < 64) *(u32x2*)(Et + (bufi) * 256 + tid * 4) = ereg; } while (0)
    ATT_LOAD(0); ATT_WRITE(0);
    __syncthreads();
    for (int t = 0; t < NT; ++t) {
        const int cur = t & 1;
        if (t + 1 < NT) ATT_LOAD(t + 1);
        if (64 * t <= q0 + 31) {
            const bf16_t* kb_ = Kt + cur * 4608; const bf16_t* vb_ = Vt + cur * 4352; const bf16_t* eb_ = Et + cur * 256;
            f32x16 st0, st1;
#pragma unroll
            for (int r = 0; r < 16; ++r) { st0[r] = 0.f; st1[r] = 0.f; }
#pragma unroll
            for (int s = 0; s < 4; ++s) {
                const bf16x8 k0 = *(const bf16x8*)(kb_ + r32 * 72 + 16 * s + 8 * hi), k1 = *(const bf16x8*)(kb_ + (32 + r32) * 72 + 16 * s + 8 * hi);
                st0 = __builtin_amdgcn_mfma_f32_32x32x16_bf16(k0, qf[s], st0, 0, 0, 0);
                st1 = __builtin_amdgcn_mfma_f32_32x32x16_bf16(k1, qf[s], st1, 0, 0, 0);
            }
            {
                bf16x8 e0 = (bf16x8){0, 0, 0, 0, 0, 0, 0, 0}, e1 = e0;
                if (hi == 0) {
                    const u32x2 x0 = *(const u32x2*)(eb_ + r32 * 4), x1 = *(const u32x2*)(eb_ + (32 + r32) * 4);
                    e0[0] = (short)(x0.x & 0xffffu); e0[1] = (short)(x0.x >> 16); e0[2] = (short)(x0.y & 0xffffu);
                    e1[0] = (short)(x1.x & 0xffffu); e1[1] = (short)(x1.x >> 16); e1[2] = (short)(x1.y & 0xffffu);
                }
                st0 = __builtin_amdgcn_mfma_f32_32x32x16_bf16(e0, qx, st0, 0, 0, 0);
                st1 = __builtin_amdgcn_mfma_f32_32x32x16_bf16(e1, qx, st1, 0, 0, 0);
            }
            if (64 * t + 63 > q0) {
                const int qi = q0 + r32;
#pragma unroll
                for (int r = 0; r < 16; ++r) { const int kv = 64 * t + crow(r, hi); if (kv > qi) st0[r] = -INFINITY; if (kv + 32 > qi) st1[r] = -INFINITY; }
            }
            float mx = fmaxf(st0[0], st1[0]);
#pragma unroll
            for (int r = 1; r < 16; ++r) mx = fmaxf(mx, fmaxf(st0[r], st1[r]));
            mx = fmaxf(mx, __shfl_xor(mx, 32));
            const float mnew = fmaxf(mrun, mx);
            const float alpha = __builtin_amdgcn_exp2f(mrun - mnew);
            mrun = mnew;
            float rs = 0.f;
#pragma unroll
            for (int r = 0; r < 16; ++r) { st0[r] = __builtin_amdgcn_exp2f(st0[r] - mnew); st1[r] = __builtin_amdgcn_exp2f(st1[r] - mnew); rs += st0[r] + st1[r]; }
            lrun = lrun * alpha + rs;
#pragma unroll
            for (int r = 0; r < 16; ++r) { ot0[r] *= alpha; ot1[r] *= alpha; }
#pragma unroll
            for (int sp = 0; sp < 4; ++sp) {
                const int base = 8 * (sp & 1);
                u32x4 pw;
                if (sp < 2) { pw.x = cvt_pk_bf16(st0[base + 0], st0[base + 1]); pw.y = cvt_pk_bf16(st0[base + 2], st0[base + 3]); pw.z = cvt_pk_bf16(st0[base + 4], st0[base + 5]); pw.w = cvt_pk_bf16(st0[base + 6], st0[base + 7]); }
                else        { pw.x = cvt_pk_bf16(st1[base + 0], st1[base + 1]); pw.y = cvt_pk_bf16(st1[base + 2], st1[base + 3]); pw.z = cvt_pk_bf16(st1[base + 4], st1[base + 5]); pw.w = cvt_pk_bf16(st1[base + 6], st1[base + 7]); }
                const bf16x8 pf = __builtin_bit_cast(bf16x8, pw);
                {
                    const bf16_t* vp = vb_ + r32 * 68 + 16 * sp + 4 * hi;
                    const u32x2 lo = *(const u32x2*)vp, hi2 = *(const u32x2*)(vp + 8);
                    const bf16x8 vf = __builtin_bit_cast(bf16x8, (u32x4){lo.x, lo.y, hi2.x, hi2.y});
                    ot0 = __builtin_amdgcn_mfma_f32_32x32x16_bf16(vf, pf, ot0, 0, 0, 0);
                }
                {
                    const bf16_t* vp = vb_ + (32 + r32) * 68 + 16 * sp + 4 * hi;
                    const u32x2 lo = *(const u32x2*)vp, hi2 = *(const u32x2*)(vp + 8);
                    const bf16x8 vf = __builtin_bit_cast(bf16x8, (u32x4){lo.x, lo.y, hi2.x, hi2.y});
                    ot1 = __builtin_amdgcn_mfma_f32_32x32x16_bf16(vf, pf, ot1, 0, 0, 0);
                }
            }
        }
        if (t + 1 < NT) ATT_WRITE(cur ^ 1);
        __syncthreads();
    }
#undef ATT_LOAD
#undef ATT_WRITE
    {
        const float lt = lrun + __shfl_xor(lrun, 32); const float inv = 1.0f / lt;
        float ss = 0.f;
#pragma unroll
        for (int r = 0; r < 16; ++r) { ot0[r] *= inv; ot1[r] *= inv; ss += ot0[r] * ot0[r] + ot1[r] * ot1[r]; }
        ss += __shfl_xor(ss, 32);
        const float rinv = rsqrtf(ss * (1.f / 64.f) + 1e-6f);
        const size_t row = tokbase + q0 + r32;
        const float* fog = a.in[20];
#pragma unroll
        for (int dh = 0; dh < 2; ++dh)
#pragma unroll
            for (int g = 0; g < 4; ++g) {
                const int col = h * 64 + 32 * dh + 8 * g + 4 * hi;
                const u32x2 og = *(const u32x2*)(OG + row * 1024 + col); const f32x4 gg = *(const f32x4*)(fog + col);
                float o[4];
#pragma unroll
                for (int j = 0; j < 4; ++j) o[j] = (dh == 0 ? ot0[4 * g + j] : ot1[4 * g + j]) * rinv * gg[j];
                u32x2 wv; wv.x = pk2(o[0] * bflo(og.x), o[1] * bfhi(og.x)); wv.y = pk2(o[2] * bflo(og.y), o[3] * bfhi(og.y));
                *(u32x2*)(YM + row * DM + 1024 + col) = wv;
            }
    }
}

__device__ __forceinline__ void sattn_unit(const Args& a, unsigned char* lds, int bh) {
    const int tid = threadIdx.x, lane = tid & 63, w = tid >> 6;
    const int b = bh >> 4, h = bh & 15;
    unsigned char* ws = a.ws;
    const bf16_t* Q = (const bf16_t*)(ws + WS_Q); const bf16_t* OG = (const bf16_t*)(ws + WS_OG); bf16_t* YM = (bf16_t*)(ws + WS_YMIX);
    const float* ck = a.in[2]; const float* cv = a.in[3]; const float* clf = a.in[4];
    float* qs = (float*)lds;
    float* cb = qs + 1024;
    float* sc = cb + 1088;
    float* red = sc + 16640;
    for (int i = tid; i < 1024; i += 512) { const int q = i >> 6, d = i & 63; qs[i] = bf2f(Q[(size_t)(MP + b * 16 + q) * 1024 + h * 64 + d]); }
    if (w == 0) {
        const int e0 = lane * 17; float loc = 0.f;
        for (int i = 0; i < 17; ++i) { const int e = e0 + i; if (e < 1040) loc += (e < 1024) ? clf[((size_t)b * 1024 + e) * 16 + h] : a.out[OFF_SLOGF + (size_t)(b * 16 + e - 1024) * 16 + h]; }
        float inc = loc;
#pragma unroll
        for (int o = 1; o < 64; o <<= 1) { const float n = __shfl_up(inc, o); if (lane >= o) inc += n; }
        float run = inc - loc;
        for (int i = 0; i < 17; ++i) { const int e = e0 + i; if (e < 1040) { run += (e < 1024) ? clf[((size_t)b * 1024 + e) * 16 + h] : a.out[OFF_SLOGF + (size_t)(b * 16 + e - 1024) * 16 + h]; cb[e] = -run * LOG2E; } }
    }
    __syncthreads();
#pragma unroll 1
    for (int it = 0; it < 3; ++it) {
        const int j = tid + 512 * it;
        if (j < 1040) {
            const float* kp = (j < 1024) ? ck + (((size_t)b * 1024 + j) * 16 + h) * 64 : a.out + OFF_SK + ((size_t)(b * 16 + j - 1024) * 16 + h) * 64;
            f32x4 kv[16];
#pragma unroll
            for (int i = 0; i < 16; ++i) kv[i] = *(const f32x4*)(kp + 4 * i);
            const float bias = cb[j];
#pragma unroll 1
            for (int q = 0; q < 16; ++q) {
                const f32x4* qp = (const f32x4*)(qs + q * 64);
                float d0 = 0.f, d1 = 0.f;
#pragma unroll
                for (int i = 0; i < 16; i += 2) { const f32x4 x = qp[i], y = qp[i + 1];
                    d0 += x[0] * kv[i][0] + x[1] * kv[i][1] + x[2] * kv[i][2] + x[3] * kv[i][3];
                    d1 += y[0] * kv[i + 1][0] + y[1] * kv[i + 1][1] + y[2] * kv[i + 1][2] + y[3] * kv[i + 1][3]; }
                float sv = d0 + d1 + bias;
                if (j >= 1024 && j - 1024 > q) sv = -INFINITY;
                sc[q * 1040 + j] = sv;
            }
        }
    }
    __syncthreads();
    for (int qq = 0; qq < 2; ++qq) {
        float* sr = sc + (2 * w + qq) * 1040;
        float mx = -INFINITY;
        for (int j = lane; j < 1040; j += 64) mx = fmaxf(mx, sr[j]);
        mx = wave_max(mx);
        float sum = 0.f;
        for (int j = lane; j < 1040; j += 64) { const float p = __builtin_amdgcn_exp2f(sr[j] - mx); sr[j] = p; sum += p; }
        sum = wave_sum(sum);
        const float inv = 1.0f / sum;
        for (int j = lane; j < 1040; j += 64) sr[j] *= inv;
    }
    __syncthreads();
    {
        float acc[16];
#pragma unroll
        for (int q = 0; q < 16; ++q) acc[q] = 0.f;
        const float* vbase = cv + (((size_t)b * 1024) * 16 + h) * 64 + lane;
#pragma unroll 16
        for (int j = w; j < 1024; j += 8) {
            const float vv = vbase[(size_t)j * 1024];
#pragma unroll
            for (int q = 0; q < 16; ++q) acc[q] = fmaf(sc[q * 1040 + j], vv, acc[q]);
        }
        for (int j = 1024 + w; j < 1040; j += 8) {
            const float vv = a.out[OFF_SV + ((size_t)(b * 16 + j - 1024) * 16 + h) * 64 + lane];
#pragma unroll
            for (int q = 0; q < 16; ++q) acc[q] = fmaf(sc[q * 1040 + j], vv, acc[q]);
        }
#pragma unroll
        for (int q = 0; q < 16; ++q) red[(w * 16 + q) * 64 + lane] = acc[q];
    }
    __syncthreads();
    for (int pass = 0; pass < 2; ++pass) {
        const int q = w + 8 * pass;
        float o = 0.f;
#pragma unroll
        for (int ww = 0; ww < 8; ++ww) o += red[(ww * 16 + q) * 64 + lane];
        const float ss = wave_sum(o * o);
        const float rinv = rsqrtf(ss * (1.f / 64.f) + 1e-6f);
        const size_t row = (size_t)(MP + b * 16 + q); const int col = h * 64 + lane;
        const float y = o * rinv * a.in[20][col] * bf2f(OG[row * 1024 + col]);
        YM[row * DM + 1024 + col] = (bf16_t)f2bf(y);
    }
    __syncthreads();
}

__device__ __forceinline__ int next_work(unsigned* ctr, unsigned char* lds) {
    volatile unsigned* wordp = (volatile unsigned*)(lds + LDS_WORD_OFF);
    if (threadIdx.x == 0) *wordp = __hip_atomic_fetch_add(ctr, 1u, __ATOMIC_RELAXED, __HIP_MEMORY_SCOPE_AGENT);
    __syncthreads();
    const int v = (int)*wordp;
    __syncthreads();
    return v;
}

#define GAS __attribute__((address_space(1)))
#define RLX_AGENT __ATOMIC_RELAXED, __HIP_MEMORY_SCOPE_AGENT
#define XB_TMO      128
#define XB_XCNT(j)  (256  + 64 * (j))
#define XB_XSUB(j)  (1280 + 64 * (j))
#define XB_XGEN(j)  (2304 + 64 * (j))
#define XB_TOP      3328
#define XB_TOPGEN   3392
#define XCD_BAR_WORDS 3456
#define XB_SPIN_CAP (1u << 18)

__device__ __forceinline__ unsigned xb_ld(unsigned* p)              { return __hip_atomic_load(p, __ATOMIC_RELAXED, __HIP_MEMORY_SCOPE_AGENT); }
__device__ __forceinline__ unsigned xb_add(unsigned* p, unsigned v) { return __hip_atomic_fetch_add(p, v, __ATOMIC_RELAXED, __HIP_MEMORY_SCOPE_AGENT); }
__device__ __forceinline__ unsigned xb_xcc_id() { return (unsigned)__builtin_amdgcn_s_getreg((3 << 11) | 20) & 0xFu; }
#define XB_SPIN(cond, bar) do { unsigned _sp = 0; while (cond) { __builtin_amdgcn_s_sleep(1); \
    if ((++_sp & 255u) == 0u) { if (xb_ld(&(bar)[XB_TMO])) break; if (_sp > XB_SPIN_CAP) { atomicAdd(&(bar)[XB_TMO], 1u); break; } } } } while (0)

struct XcdBarrier {
    unsigned* bar; unsigned x;
    volatile LAS unsigned* st;
};

__device__ __forceinline__ XcdBarrier xcd_barrier_post(unsigned* bar, volatile LAS unsigned* st) {
    XcdBarrier b; b.bar = bar; b.x = xb_xcc_id(); b.st = st;
    if (threadIdx.x == 0) (void)xb_add(&bar[XB_XCNT(b.x)], 1u);
    return b;
}
__device__ __forceinline__ void xcd_barrier_complete(unsigned* bar, unsigned x, unsigned& nloc, unsigned& nx) {
    const unsigned G = gridDim.x * gridDim.y * gridDim.z;
    unsigned sum, cnt, mine, sp = 0u;
    for (;;) {
        sum = 0u; cnt = 0u; mine = 0u;
#pragma unroll
        for (unsigned j = 0; j < 16; ++j) { const unsigned c = xb_ld(&bar[XB_XCNT(j)]); sum += c; cnt += (c > 0u) ? 1u : 0u; mine = (j == x) ? c : mine; }
        if (sum == G) break;
        __builtin_amdgcn_s_sleep(1);
        if ((++sp & 255u) == 0u) { if (xb_ld(&bar[XB_TMO])) break; if (sp > XB_SPIN_CAP) { atomicAdd(&bar[XB_TMO], 1u); break; } }
    }
    nloc = mine > 0u ? mine : 1u; nx = cnt > 0u ? cnt : 1u;
}

__device__ __forceinline__ void xcd_barrier(const XcdBarrier& b) {
    asm volatile("s_waitcnt vmcnt(0)" ::: "memory");
    __syncthreads();
    if (threadIdx.x == 0) {
        unsigned* bar = b.bar;
        __builtin_amdgcn_s_waitcnt(0);
        unsigned nloc = b.st[0], nx = b.st[1];
        if (nloc == 0u) { xcd_barrier_complete(bar, b.x, nloc, nx); b.st[0] = nloc; b.st[1] = nx; }
        const unsigned old = xb_add(&bar[XB_XSUB(b.x)], 1u);
        const unsigned gen = old / nloc;
        if (old + 1u == (gen + 1u) * nloc) {
            __builtin_amdgcn_fence(__ATOMIC_RELEASE, "agent");
            asm volatile("s_waitcnt vmcnt(0)" ::: "memory");
            const unsigned og = xb_add(&bar[XB_TOP], 1u);
            const unsigned tg = og / nx;
            if (og + 1u == (tg + 1u) * nx) xb_add(&bar[XB_TOPGEN], 1u);
            else XB_SPIN(xb_ld(&bar[XB_TOPGEN]) == tg, bar);
            __builtin_amdgcn_fence(__ATOMIC_ACQUIRE, "agent");
            xb_add(&bar[XB_XGEN(b.x)], 1u);
            asm volatile("s_waitcnt vmcnt(0)" ::: "memory");
        } else {
            XB_SPIN(xb_ld(&bar[XB_XGEN(b.x)]) == gen, bar);
            __builtin_amdgcn_fence(__ATOMIC_ACQUIRE, "agent");
            asm volatile("s_waitcnt vmcnt(0)" ::: "memory");
        }
    }
    __syncthreads();
}

__global__ void __launch_bounds__(512, 2) mk_fwd(Args a) {
    extern __shared__ __attribute__((aligned(16))) unsigned char lds[];
    LAS unsigned char* ldsl = (LAS unsigned char*)lds;
    const int lo = a.ph_lo, hi = a.ph_hi, G = gridDim.x;
    unsigned char* ws = a.ws;
#ifndef PH_MASK
#define PH_MASK 0x7ff
#endif
#define IN(k) (((PH_MASK >> (k)) & 1) && lo <= (k) && (k) < hi)
    if (threadIdx.x < 4) ((LAS unsigned*)(ldsl + LDS_BARW_OFF))[threadIdx.x] = 0u;
    __syncthreads();
    XcdBarrier bar = xcd_barrier_post((unsigned*)(ws + WS_CTL) + CW_BAR, (volatile LAS unsigned*)(ldsl + LDS_BARW_OFF));
    if (a.ph_hi > 1000) cg::this_grid().sync();
#define SEAM(k) do { if (IN(k) && IN((k) + 1)) xcd_barrier(bar); } while (0)
    if (IN(0)) { phase0(a, ldsl); }
    SEAM(0);
    if (IN(1)) {
        Gemm g{(const bf16_t*)(ws + WS_XB), (const bf16_t*)(ws + WS_WIN), MT, NIN, DM}; StaticOrder S; S.init(MT, NIN, DM, G, (int)blockIdx.x);
        EpiIn E{(bf16_t*)(ws + WS_PR), (bf16_t*)(ws + WS_Q), (bf16_t*)(ws + WS_KB), (bf16_t*)(ws + WS_VT), (bf16_t*)(ws + WS_OG), a.out, a.in[19]};
        gemm_phase<EpiIn, StaticOrder, true, true>(ldsl, g, S, E);
    }
    SEAM(1);
    if (IN(2)) { phase2(a); }
    SEAM(2);
    if (IN(3)) {
        Gemm g{(const bf16_t*)(ws + WS_LIN), (const bf16_t*)(ws + WS_LORA), MT, NL, KL}; StaticOrder S; S.init(MT, NL, KL, G, (int)blockIdx.x);
        EpiLora E{(float*)(ws + WS_W), (bf16_t*)(ws + WS_ALR), (bf16_t*)(ws + WS_G), a.in[9], a.in[11]};
        gemm_phase<EpiLora, StaticOrder, true, true>(ldsl, g, S, E);
    }
    SEAM(3);
    if (IN(4)) {
        unsigned* ctr = (unsigned*)(ws + WS_CTL) + 128 * a.rep;
        const int pm_ = a.pad ? a.pad : 7;
        if (blockIdx.x < 128) { if (pm_ & 1) { const int sb = (int)blockIdx.x; const int bh = (sb & 7) * 4 + ((sb >> 3) >> 2); scan_unit<false>(a, lds, bh >> 4, bh & 15, (sb >> 3) & 3, sb); } }
        else if (pm_ & 2) { for (;;) { const int i = next_work(ctr, lds); if (i >= 512) break; attn_unit(a, lds, i & 31, 15 - (i >> 5)); } }
        if (pm_ & 4) for (;;) { const int j = next_work(ctr + 64, lds); if (j >= 640) break;
            if (j < 128) sattn_unit(a, lds, j); else { const int u = j - 128; scan_unit<true>(a, lds, u >> 6, (u >> 2) & 15, u & 3, 0); } }
    }
    SEAM(4);
    if (IN(5)) { phase_gn(a); }
    SEAM(5);
    if (IN(6)) {
        Gemm g{(const bf16_t*)(ws + WS_YMIX), (const bf16_t*)(ws + WS_WO), MT, DM, DM}; SplitOrder S; S.init(DM, DM, G, (int)blockIdx.x, 512);
        EpiRes E{a.in[0], nullptr, a.out, (float*)(ws + WS_SLAB1), 512};
        gemm_phase<EpiRes, SplitOrder, true, true>(ldsl, g, S, E);
    }
    SEAM(6);
    if (IN(7)) { ln_phase(a.out, a.in[22], a.in[23], (bf16_t*)(ws + WS_HB), a.in[1], (const float*)(ws + WS_SLAB1), 4); }
    SEAM(7);
    if (IN(8)) {
        Gemm g{(const bf16_t*)(ws + WS_HB), (const bf16_t*)(ws + WS_WUP), MT, DFF, DM}; StaticOrder S; S.init(MT, DFF, DM, G, (int)blockIdx.x);
        EpiUp E{(bf16_t*)(ws + WS_U)};
        gemm_phase<EpiUp, StaticOrder, true, true>(ldsl, g, S, E);
    }
    SEAM(8);
    if (IN(9)) {
        Gemm g{(const bf16_t*)(ws + WS_U), (const bf16_t*)(ws + WS_WDN), MT, DM, DFF}; SplitOrder S; S.init(DM, DFF, G, (int)blockIdx.x, 1024);
        EpiRes E{nullptr, (const bf16_t*)(ws + WS_HB), a.out, (float*)(ws + WS_SLAB2), 1024};
        gemm_phase<EpiRes, SplitOrder, true, true>(ldsl, g, S, E);
    }
    SEAM(9);
    if (IN(10)) { ln_phase(a.out, a.in[26], a.in[27], nullptr, a.out + OFF_YS, (const float*)(ws + WS_SLAB2), 8); }
#undef IN
#undef SEAM
}
}

extern "C" void kernel_launch(void* const* d_in, const int* in_sizes, int n_in, void* d_out, int out_size, void* d_ws, size_t ws_size, hipStream_t stream) {
    using namespace pg8;
    static int grid = 0;
    if (grid == 0) {
        if (n_in != 28 || (size_t)out_size != OUT_TOTAL || ws_size < WS_END) { fprintf(stderr, "kernel_launch: unexpected problem (n_in %d, out %d, ws %zu); nothing launched\n", n_in, out_size, ws_size); grid = -1; return; }
        int dev = 0, cus = 0, per_cu = 0;
        if (hipGetDevice(&dev) != hipSuccess || hipDeviceGetAttribute(&cus, hipDeviceAttributeMultiprocessorCount, dev) != hipSuccess) { grid = -1; return; }
        if (hipFuncSetAttribute((const void*)mk_fwd, hipFuncAttributeMaxDynamicSharedMemorySize, LDS_BYTES) != hipSuccess) { fprintf(stderr, "kernel_launch: hipFuncSetAttribute failed\n"); grid = -1; return; }
        if (hipOccupancyMaxActiveBlocksPerMultiprocessor(&per_cu, (const void*)mk_fwd, 512, LDS_BYTES) != hipSuccess || per_cu < 1) { fprintf(stderr, "kernel_launch: occupancy query says %d\n", per_cu); per_cu = 1; }
        (void)hipGetLastError();
        grid = cus;
    }
    if (grid < 0) return;
    if (hipMemsetAsync((char*)d_ws + WS_CTL, 0, 65536, stream) != hipSuccess) { fprintf(stderr, "kernel_launch: hipMemsetAsync failed\n"); return; }
    Args a{};
    for (int i = 0; i < 28; ++i) a.in[i] = (const float*)d_in[i];
    a.out = (float*)d_out; a.ws = (unsigned char*)d_ws;
#if ONE_LAUNCH
    a.ph_lo = 0; a.ph_hi = NPH;
    void* args[] = {&a};
    hipError_t e = hipLaunchCooperativeKernel((const void*)mk_fwd, dim3(grid), dim3(512), args, LDS_BYTES, stream);
    if (e != hipSuccess) fprintf(stderr, "kernel_launch: cooperative launch failed: %s (grid %d)\n", hipGetErrorString(e), grid);
#else
#ifndef PROBE_DUP
#define PROBE_DUP -1
#endif
#ifndef PROBE_MODE
#define PROBE_MODE 0
#endif
    for (int p = 0; p < NPH; ++p) { a.ph_lo = p; a.ph_hi = p + 1; a.rep = 0; a.pad = 0; hipLaunchKernelGGL(mk_fwd, dim3(grid), dim3(512), LDS_BYTES, stream, a);
        if (p == PROBE_DUP) { a.rep = 1; a.pad = PROBE_MODE; hipLaunchKernelGGL(mk_fwd, dim3(grid), dim3(512), LDS_BYTES, stream, a); } }
#endif
}
```

```cpp
#include <hip/hip_runtime.h>
#include <hip/hip_cooperative_groups.h>
#include <cstdio>
#include <cstdint>
namespace pg8 {
#define PG8_LAS __attribute__((address_space(3)))
typedef unsigned short bf16_t;
typedef short bf16x8 __attribute__((ext_vector_type(8)));
typedef float f32x4 __attribute__((ext_vector_type(4)));
typedef unsigned u32x4 __attribute__((ext_vector_type(4)));
constexpr int BM = 256, BK = 64, HALF = 128, HTB = HALF * BK * 2  , STAGE_BYTES = 8 * HTB, NXCD = 8, WGM = 8;

__host__ __device__ __forceinline__ int lds_byte(int r, int c) { const int st = (r >> 4) * 2 + (c >> 5), rr = r & 15, cc = c & 31, ob = rr * 64 + cc * 2; return st * 1024 + (ob ^ (((ob >> 9) & 1) << 5)); }
__host__ __device__ __forceinline__ void stage_rc(int b, int& R, int& C) { const int st = b / 1024, sb = b % 1024, swz = sb ^ (((sb >> 9) & 1) << 5); R = (st >> 1) * 16 + swz / 64; C = (st & 1) * 32 + (swz % 64) / 2; }
__host__ __device__ __forceinline__ int perm32(int rho) { const int n = rho >> 4, i = rho & 15; return 8 * (i >> 2) + 4 * n + (i & 3); }

struct Unit { int pm, pn, k0, nt, smp; };
struct Gemm { const bf16_t* A; const bf16_t* Bt; int M, N, K; };

struct StaticOrder {
    int nM, nN, nwg, G, c, ntk;
    __host__ __device__ void init(int M, int N, int K, int G_, int c_) { nM = M / BM; nN = N / BM; nwg = nM * nN; G = G_; c = c_; ntk = K / BK; }
    __host__ __device__ bool next(int i, Unit& u) const {
        const long L = (long)i * G + c; if (L >= nwg) return false;
        int wgid = (int)L; { const int q = nwg / NXCD, r = nwg % NXCD, xcd = wgid % NXCD, off = wgid / NXCD; wgid = (xcd < r ? xcd * (q + 1) : r * (q + 1) + (xcd - r) * q) + off; }
        const int nig = WGM * nN, gid = wgid / nig, fm = gid * WGM, gsz = (nM - fm) < WGM ? (nM - fm) : WGM;
        u.pm = fm + ((wgid % nig) % gsz); u.pn = (wgid % nig) / gsz; u.k0 = 0; u.nt = ntk; u.smp = 0; return true;
    }
    __device__ __forceinline__ void a_ready(const Unit&) const {}
    __device__ __forceinline__ void done(const Unit&) const {}
};

struct SplitOrder {
    StaticOrder P; int nN, nks, KC;
    __host__ __device__ void init(int N, int K, int G_, int c_, int KC_) { P.init(8192, N, K, G_, c_); nN = N / BM; KC = KC_; nks = K / KC_; }
    __host__ __device__ bool next(int i, Unit& u) const {
        const long L = (long)i * P.G + P.c;
        if (L < P.nwg) return P.next(i, u);
        const int idx = (int)(L - P.nwg); if (idx >= nN * nks) return false;
        u.pm = 32; u.pn = idx % nN; u.k0 = (idx / nN) * KC; u.nt = KC / BK; u.smp = 1; return true;
    }
    __device__ __forceinline__ void a_ready(const Unit&) const {}
    __device__ __forceinline__ void done(const Unit&) const {}
};

__device__ __forceinline__ unsigned cvt_pk_bf16(float lo, float hi) { unsigned r; asm volatile("v_cvt_pk_bf16_f32 %0, %1, %2" : "=v"(r) : "v"(lo), "v"(hi)); return r; }
template <class Epi, class Sched, bool ALIGN_EPI = false, bool SP2 = false>
__device__ __forceinline__ void gemm_phase(PG8_LAS unsigned char* lds, const Gemm g, const Sched& S, const Epi& E) {
    const int tid = threadIdx.x, wid = __builtin_amdgcn_readfirstlane(tid >> 6), lane = tid & 63, wr = wid >> 2, wc = wid & 3, fr = lane & 15, fq = lane >> 4;
    const int K = g.K;
    unsigned voffA[2], voffB[2];
#pragma unroll
    for (int i = 0; i < 2; ++i) { int R, C; stage_rc(tid * 16 + i * 8192, R, C); const int Rb = Epi::PERM ? ((R & ~31) + perm32(R & 31)) : R;
        voffA[i] = (unsigned)(R * K + C) * 2u; voffB[i] = (unsigned)(Rb * K + C) * 2u; }
    const size_t kstep = (size_t)(BK * 2);
    const size_t hstep = (size_t)HALF * K * 2;
    const size_t tstep = 2 * hstep;
    const unsigned ldsw = (unsigned)wid * 1024u;
    const int aoff = lds_byte(wr * 64 + fr, fq * 8), boff = lds_byte(wc * 32 + fr, fq * 8);
#define PG8_SA(b, h) (((b) * 2 + (h)) * HTB)
#define PG8_SB(b, h) ((4 + (b) * 2 + (h)) * HTB)
#define PG8_STAGE(bufoff, gbase, voff) do { _Pragma("unroll") for (int _i = 0; _i < 2; ++_i) \
        __builtin_amdgcn_global_load_lds((const unsigned*)((const char*)(gbase) + (voff)[_i]), (PG8_LAS unsigned*)(lds + (bufoff) + ldsw + _i * 8192), 16, 0, 0); } while (0)
#define PG8_LDA(dst, b, h) do { _Pragma("unroll") for (int m = 0; m < 4; ++m) _Pragma("unroll") for (int k = 0; k < 2; ++k) dst[m][k] = *(const PG8_LAS bf16x8*)(lds + PG8_SA(b, h) + aoff + m * 2048 + k * 1024); } while (0)
#define PG8_LDB(dst, b, h) do { _Pragma("unroll") for (int n = 0; n < 2; ++n) _Pragma("unroll") for (int k = 0; k < 2; ++k) dst[n][k] = *(const PG8_LAS bf16x8*)(lds + PG8_SB(b, h) + boff + n * 2048 + k * 1024); } while (0)
#define PG8_MMA(ai, bj, At, Bt) do { __builtin_amdgcn_s_setprio(1); _Pragma("unroll") for (int m = 0; m < 4; ++m) _Pragma("unroll") for (int n = 0; n < 2; ++n) _Pragma("unroll") for (int k = 0; k < 2; ++k) \
        acc[ai][bj][m][n] = __builtin_amdgcn_mfma_f32_16x16x32_bf16(Bt[n][k], At[m][k], acc[ai][bj][m][n], 0, 0, 0); __builtin_amdgcn_s_setprio(0); } while (0)
#define PG8_WAIT_V(n) asm volatile("s_waitcnt vmcnt(" #n ")" ::: "memory")
#define PG8_WAIT_L(n) asm volatile("s_waitcnt lgkmcnt(" #n ")" ::: "memory")
#define PG8_BAR __builtin_amdgcn_s_barrier()
#define PG8_SCHED __builtin_amdgcn_sched_barrier(0)
    Unit cur, nxt; int ui = 0;
    if (!S.next(0, cur)) return;
    f32x4 acc[2][2][4][2];
#pragma unroll
    for (int a = 0; a < 2; ++a)
#pragma unroll
        for (int b = 0; b < 2; ++b)
#pragma unroll
            for (int m = 0; m < 4; ++m)
#pragma unroll
                for (int n = 0; n < 2; ++n) acc[a][b][m][n] = (f32x4){0.f, 0.f, 0.f, 0.f};
    bf16x8 At[4][2], B0[2][2], B1[2][2];
    const char* cA = (const char*)g.A + (size_t)cur.pm * tstep + (size_t)cur.k0 * 2; const char* cB = (const char*)g.Bt + (size_t)cur.pn * tstep + (size_t)cur.k0 * 2;
    S.a_ready(cur);
    if constexpr (SP2) {
        PG8_STAGE(PG8_SB(0, 0), cB, voffB); PG8_STAGE(PG8_SB(0, 1), cB + hstep, voffB); PG8_STAGE(PG8_SA(0, 0), cA, voffA); PG8_STAGE(PG8_SA(0, 1), cA + hstep, voffA);
        if (wr == 1) PG8_BAR;
        PG8_WAIT_V(2); PG8_BAR;
        PG8_STAGE(PG8_SB(1, 0), cB + kstep, voffB); PG8_STAGE(PG8_SA(1, 0), cA + kstep, voffA); PG8_STAGE(PG8_SB(1, 1), cB + hstep + kstep, voffB);
        PG8_WAIT_V(6); PG8_BAR;
    } else {
        PG8_STAGE(PG8_SB(0, 0), cB, voffB); PG8_STAGE(PG8_SA(0, 0), cA, voffA); PG8_STAGE(PG8_SB(0, 1), cB + hstep, voffB); PG8_STAGE(PG8_SA(0, 1), cA + hstep, voffA);
        if (wr == 1) PG8_BAR;
        PG8_WAIT_V(4); PG8_BAR;
        PG8_STAGE(PG8_SB(1, 0), cB + kstep, voffB); PG8_STAGE(PG8_SA(1, 0), cA + kstep, voffA); PG8_STAGE(PG8_SB(1, 1), cB + hstep + kstep, voffB);
        PG8_WAIT_V(6); PG8_BAR;
    }
    for (;;) {
        const bool has_next = S.next(ui + 1, nxt);
        const char* nA = has_next ? (const char*)g.A + (size_t)nxt.pm * tstep + (size_t)nxt.k0 * 2 : cA; const char* nB = has_next ? (const char*)g.Bt + (size_t)nxt.pn * tstep + (size_t)nxt.k0 * 2 : cB;
        const int nt = cur.nt;
        for (int t = 0; t < nt; t += 2) {
            const bool last = (t == nt - 2);
            const char* a1 = cA + (size_t)(t + 1) * kstep;
            const char* a2 = last ? nA : cA + (size_t)(t + 2) * kstep; const char* b2 = last ? nB : cB + (size_t)(t + 2) * kstep;
            const char* a3 = a2 + kstep; const char* b3 = b2 + kstep;
            if (last && has_next) S.a_ready(nxt);
            if constexpr (SP2) {
            PG8_LDB(B0, 0, 0); PG8_LDB(B1, 0, 1); PG8_SCHED; PG8_LDA(At, 0, 0); PG8_STAGE(PG8_SA(1, 1), a1 + hstep, voffA);
            PG8_WAIT_V(8); PG8_WAIT_L(0); PG8_BAR; PG8_MMA(0, 0, At, B0); PG8_MMA(0, 1, At, B1); PG8_BAR; PG8_SCHED;
            PG8_LDA(At, 0, 1); PG8_STAGE(PG8_SB(0, 0), b2, voffB); PG8_STAGE(PG8_SB(0, 1), b2 + hstep, voffB); PG8_STAGE(PG8_SA(0, 0), a2, voffA);
            PG8_WAIT_V(8); PG8_WAIT_L(0); PG8_BAR; PG8_MMA(1, 0, At, B0); PG8_MMA(1, 1, At, B1); PG8_BAR; PG8_SCHED;
            PG8_LDB(B0, 1, 0); PG8_LDB(B1, 1, 1); PG8_SCHED; PG8_LDA(At, 1, 0); PG8_STAGE(PG8_SA(0, 1), a2 + hstep, voffA);
            PG8_WAIT_V(8); PG8_WAIT_L(0); PG8_BAR; PG8_MMA(0, 0, At, B0); PG8_MMA(0, 1, At, B1); PG8_BAR; PG8_SCHED;
            PG8_LDA(At, 1, 1); PG8_STAGE(PG8_SB(1, 0), b3, voffB); PG8_STAGE(PG8_SB(1, 1), b3 + hstep, voffB); PG8_STAGE(PG8_SA(1, 0), a3, voffA);
            PG8_WAIT_V(8); PG8_WAIT_L(0); PG8_BAR; PG8_MMA(1, 0, At, B0); PG8_MMA(1, 1, At, B1); PG8_BAR; PG8_SCHED;
            } else {
            PG8_LDB(B0, 0, 0); PG8_SCHED; PG8_LDA(At, 0, 0); PG8_STAGE(PG8_SA(1, 1), a1 + hstep, voffA);
            PG8_WAIT_L(8); PG8_BAR; PG8_WAIT_L(0); PG8_MMA(0, 0, At, B0); PG8_BAR; PG8_SCHED;
            PG8_LDB(B1, 0, 1); PG8_STAGE(PG8_SB(0, 0), b2, voffB);
            PG8_BAR; PG8_WAIT_L(0); PG8_MMA(0, 1, At, B1); PG8_BAR;
            PG8_LDA(At, 0, 1); PG8_STAGE(PG8_SA(0, 0), a2, voffA);
            PG8_BAR; PG8_WAIT_L(0); PG8_MMA(1, 0, At, B0); PG8_BAR; PG8_SCHED;
            PG8_STAGE(PG8_SB(0, 1), b2 + hstep, voffB);
            PG8_WAIT_V(6); PG8_BAR; PG8_MMA(1, 1, At, B1); PG8_BAR;
            PG8_LDB(B0, 1, 0); PG8_SCHED; PG8_LDA(At, 1, 0); PG8_STAGE(PG8_SA(0, 1), a2 + hstep, voffA);
            PG8_WAIT_L(8); PG8_BAR; PG8_WAIT_L(0); PG8_MMA(0, 0, At, B0); PG8_BAR; PG8_SCHED;
            PG8_LDB(B1, 1, 1); PG8_STAGE(PG8_SB(1, 0), b3, voffB);
            PG8_BAR; PG8_WAIT_L(0); PG8_MMA(0, 1, At, B1); PG8_BAR;
            PG8_LDA(At, 1, 1); PG8_STAGE(PG8_SA(1, 0), a3, voffA);
            PG8_BAR; PG8_WAIT_L(0); PG8_MMA(1, 0, At, B0); PG8_BAR; PG8_SCHED;
            PG8_STAGE(PG8_SB(1, 1), b3 + hstep, voffB);
            PG8_WAIT_V(6); PG8_BAR; PG8_MMA(1, 1, At, B1); PG8_BAR;
            }
        }
        if constexpr (ALIGN_EPI) { if (wr == 0) PG8_BAR; }
        if constexpr (!Epi::AFTER_DRAIN) { E(acc, cur, wr, wc, fr, fq); S.done(cur); }
        if (!has_next) break;
#pragma unroll
        for (int a = 0; a < 2; ++a)
#pragma unroll
            for (int b = 0; b < 2; ++b)
#pragma unroll
                for (int m = 0; m < 4; ++m)
#pragma unroll
                    for (int n = 0; n < 2; ++n) acc[a][b][m][n] = (f32x4){0.f, 0.f, 0.f, 0.f};
        cur = nxt; cA = nA; cB = nB; ++ui;
        if constexpr (ALIGN_EPI) { if (wr == 1) PG8_BAR; }
    }
    PG8_WAIT_V(0);
    if constexpr (!ALIGN_EPI) { if (wr == 0) PG8_BAR; }
    PG8_BAR;
    if constexpr (Epi::AFTER_DRAIN) { E.fused(acc, cur, wr, wc, fr, fq, lds, wid, lane); S.done(cur); }
#undef PG8_SA
#undef PG8_SB
#undef PG8_STAGE
#undef PG8_LDA
#undef PG8_LDB
#undef PG8_MMA
#undef PG8_WAIT_V
#undef PG8_WAIT_L
#undef PG8_BAR
#undef PG8_SCHED
}
}

#ifndef ONE_LAUNCH
#define ONE_LAUNCH 1
#endif
namespace cg = cooperative_groups;
namespace pg8 {
#define LAS __attribute__((address_space(3)))
typedef float f32x16 __attribute__((ext_vector_type(16)));
typedef unsigned u32x2 __attribute__((ext_vector_type(2)));
constexpr int DM = 2048, TP = 4096, MP = 8192, MR = 8320, MT = 8448;
constexpr int RPROJ = 3360, PTOT = 7472, NIN = 7680, DFF = 8192;
constexpr int C_Q = 3360, C_K = 4384, C_V = 5408, C_F = 6432, C_OG = 6448;
constexpr int KL = 384, NL = 3072;
constexpr float ALPHA_RES = 1.189207115002721f;
constexpr float LOG2E = 1.4426950408889634f;
constexpr float QSCALE = 0.125f * 1.4426950408889634f;
constexpr size_t OFF_YS = 16777216, OFF_PK = 17039360, OFF_PV = 25427968, OFF_PLOGF = 33816576, OFF_PWKV = 33947648, OFF_PSHIFT = 34078720,
                 OFF_SK = 34085440, OFF_SV = 34216512, OFF_SLOGF = 34347584, OFF_SWKV = 34349632, OFF_SSHIFT = 34873920, OUT_TOTAL = 34900800;
constexpr size_t MiB = 1u << 20;
constexpr size_t WS_CTL = 0, WS_WIN = 1 * MiB, WS_LIN = 1 * MiB, WS_G = 8 * MiB, WS_KE = 25 * MiB, WS_WO = 31 * MiB, WS_WUP = 39 * MiB, WS_WDN = 71 * MiB, WS_LORA = 103 * MiB,
                 WS_XB = 106 * MiB, WS_YMIX = 106 * MiB, WS_PR = 139 * MiB, WS_HB = 139 * MiB, WS_Q = 194 * MiB, WS_KB = 210 * MiB + MiB / 2, WS_VT = 227 * MiB, WS_OG = 243 * MiB + MiB / 2,
                 WS_SLAB1 = 1 * MiB, WS_SLAB2 = 8 * MiB, WS_W = 260 * MiB, WS_ALR = 293 * MiB, WS_U = 172 * MiB, WS_END = 310 * MiB;
constexpr int LDS_BYTES = 147456, LDS_WORD_OFF = 140032, LDS_BARW_OFF = 140096, CW_BAR = 4096;
constexpr int NPH = 11;

struct Args { const float* in[28]; float* out; unsigned char* ws; int ph_lo, ph_hi, rep, pad; };

__device__ __forceinline__ unsigned f2bf(float f) { unsigned u = __builtin_bit_cast(unsigned, f); return (u + 0x7fffu + ((u >> 16) & 1u)) >> 16; }
__device__ __forceinline__ float bf2f(unsigned h) { return __builtin_bit_cast(float, h << 16); }
__device__ __forceinline__ float bflo(unsigned p) { return __builtin_bit_cast(float, p << 16); }
__device__ __forceinline__ float bfhi(unsigned p) { return __builtin_bit_cast(float, p & 0xffff0000u); }
__device__ __forceinline__ unsigned pk2(float lo, float hi) { return f2bf(lo) | (f2bf(hi) << 16); }
__device__ __forceinline__ float sigmoidf_(float x) { return 1.0f / (1.0f + __expf(-x)); }
#define LDS_WAIT() asm volatile("s_waitcnt lgkmcnt(0)" ::: "memory")

struct EpiIn {
    static constexpr bool PERM = true, AFTER_DRAIN = false;
    bf16_t *PR, *Q, *KB, *VT, *OG; float* out; const float* b_f;
    __device__ __forceinline__ void one(const f32x4 v0, const f32x4 v1, const int row, const int c0) const {
        if (c0 < C_Q) {
            u32x4 w; w.x = cvt_pk_bf16(v0[0], v0[1]); w.y = cvt_pk_bf16(v0[2], v0[3]); w.z = cvt_pk_bf16(v1[0], v1[1]); w.w = cvt_pk_bf16(v1[2], v1[3]);
            *(u32x4*)(PR + (size_t)row * RPROJ + c0) = w;
            if (row < MP) { if ((row & (TP - 1)) == TP - 1) { float* o = out + OFF_PSHIFT + (size_t)(row >> 12) * RPROJ + c0; *(f32x4*)o = v0; *(f32x4*)(o + 4) = v1; } }
            else { const int sr = row - MP; if ((sr & 15) == 15) { float* o = out + OFF_SSHIFT + (size_t)(sr >> 4) * RPROJ + c0; *(f32x4*)o = v0; *(f32x4*)(o + 4) = v1; } }
        } else if (c0 < C_K) {
            const f32x4 a = v0 * QSCALE, b = v1 * QSCALE;
            u32x4 w; w.x = cvt_pk_bf16(a[0], a[1]); w.y = cvt_pk_bf16(a[2], a[3]); w.z = cvt_pk_bf16(b[0], b[1]); w.w = cvt_pk_bf16(b[2], b[3]);
            *(u32x4*)(Q + (size_t)row * 1024 + (c0 - C_Q)) = w;
        } else if (c0 < C_V) {
            const int col = c0 - C_K;
            float* o = (row < MP) ? out + OFF_PK + (size_t)row * 1024 + col : out + OFF_SK + (size_t)(row - MP) * 1024 + col;
            *(f32x4*)o = v0; *(f32x4*)(o + 4) = v1;
            if (row < MP) { u32x4 w; w.x = cvt_pk_bf16(v0[0], v0[1]); w.y = cvt_pk_bf16(v0[2], v0[3]); w.z = cvt_pk_bf16(v1[0], v1[1]); w.w = cvt_pk_bf16(v1[2], v1[3]);
                *(u32x4*)(KB + (size_t)row * 1024 + col) = w; }
        } else if (c0 < C_F) {
            const int col = c0 - C_V;
            float* o = (row < MP) ? out + OFF_PV + (size_t)row * 1024 + col : out + OFF_SV + (size_t)(row - MP) * 1024 + col;
            *(f32x4*)o = v0; *(f32x4*)(o + 4) = v1;
            if (row < MP) {
                const int bb = row >> 12, t = row & (TP - 1), hh = col >> 6, d0 = col & 63;
                bf16_t* vt = VT + ((size_t)(bb * 16 + hh) * 64 + d0) * TP + t;
                const unsigned p0 = cvt_pk_bf16(v0[0], v0[1]), p1 = cvt_pk_bf16(v0[2], v0[3]), p2 = cvt_pk_bf16(v1[0], v1[1]), p3 = cvt_pk_bf16(v1[2], v1[3]);
                vt[0] = (bf16_t)(p0 & 0xffffu); vt[(size_t)1 * TP] = (bf16_t)(p0 >> 16); vt[(size_t)2 * TP] = (bf16_t)(p1 & 0xffffu); vt[(size_t)3 * TP] = (bf16_t)(p1 >> 16);
                vt[(size_t)4 * TP] = (bf16_t)(p2 & 0xffffu); vt[(size_t)5 * TP] = (bf16_t)(p2 >> 16); vt[(size_t)6 * TP] = (bf16_t)(p3 & 0xffffu); vt[(size_t)7 * TP] = (bf16_t)(p3 >> 16);
            }
        } else if (c0 < C_OG) {
            const int h0 = c0 - C_F;
            float* o = (row < MP) ? out + OFF_PLOGF + (size_t)row * 16 + h0 : out + OFF_SLOGF + (size_t)(row - MP) * 16 + h0;
            f32x4 r0, r1;
#pragma unroll
            for (int j = 0; j < 4; ++j) {
                const float x0 = v0[j] + b_f[h0 + j], x1 = v1[j] + b_f[h0 + 4 + j];
                r0[j] = fminf(x0, 0.f) - __logf(1.0f + __expf(-fabsf(x0))); r1[j] = fminf(x1, 0.f) - __logf(1.0f + __expf(-fabsf(x1)));
            }
            *(f32x4*)o = r0; *(f32x4*)(o + 4) = r1;
        } else if (c0 < PTOT) {
            f32x4 a, b;
#pragma unroll
            for (int j = 0; j < 4; ++j) { a[j] = sigmoidf_(v0[j]); b[j] = sigmoidf_(v1[j]); }
            u32x4 w; w.x = cvt_pk_bf16(a[0], a[1]); w.y = cvt_pk_bf16(a[2], a[3]); w.z = cvt_pk_bf16(b[0], b[1]); w.w = cvt_pk_bf16(b[2], b[3]);
            *(u32x4*)(OG + (size_t)row * 1024 + (c0 - C_OG)) = w;
        }
    }
    template <int I> __device__ __forceinline__ void rows(const f32x4 (&acc)[2][2][4][2], const int row0, const int cb) const {
        constexpr int ai = I >> 2, m = I & 3;
        const int row = row0 + ai * HALF + m * 16;
        if (row < MR) { one(acc[ai][0][m][0], acc[ai][0][m][1], row, cb); one(acc[ai][1][m][0], acc[ai][1][m][1], row, cb + HALF); }
    }
    __device__ __forceinline__ void operator()(const f32x4 (&acc)[2][2][4][2], const Unit& u, int wr, int wc, int fr, int fq) const {
        const int row0 = u.pm * BM + wr * 64 + fr;
        const int cb = u.pn * BM + wc * 32 + 8 * fq;
        rows<0>(acc, row0, cb); rows<1>(acc, row0, cb); rows<2>(acc, row0, cb); rows<3>(acc, row0, cb);
        rows<4>(acc, row0, cb); rows<5>(acc, row0, cb); rows<6>(acc, row0, cb); rows<7>(acc, row0, cb);
    }
};

struct EpiLora {
    static constexpr bool PERM = true, AFTER_DRAIN = false;
    float* W; bf16_t *ALR, *G; const float *w0, *a0;
    template <int REG> __device__ __forceinline__ void one(const f32x4 x0, const f32x4 x1, const int row, const int c0) const {
        if (REG == 0) {
            const f32x4 v0 = x0 + *(const f32x4*)(w0 + c0), v1 = x1 + *(const f32x4*)(w0 + c0 + 4);
            f32x4 r0, r1;
#pragma unroll
            for (int j = 0; j < 4; ++j) {
                const float p0 = v0[j], p1 = v1[j];
                const float l0 = fminf(p0, 0.f) - __logf(1.0f + __expf(-fabsf(p0))) - 0.5f, l1 = fminf(p1, 0.f) - __logf(1.0f + __expf(-fabsf(p1))) - 0.5f;
                r0[j] = __expf(-__expf(l0)); r1[j] = __expf(-__expf(l1));
            }
            float* o = W + (size_t)row * 1024 + c0; *(f32x4*)o = r0; *(f32x4*)(o + 4) = r1;
        } else if (REG == 1) {
            const f32x4 v0 = x0 + *(const f32x4*)(a0 + c0 - 1024), v1 = x1 + *(const f32x4*)(a0 + c0 - 1020);
            f32x4 a, b;
#pragma unroll
            for (int j = 0; j < 4; ++j) { a[j] = sigmoidf_(v0[j]); b[j] = sigmoidf_(v1[j]); }
            u32x4 w; w.x = cvt_pk_bf16(a[0], a[1]); w.y = cvt_pk_bf16(a[2], a[3]); w.z = cvt_pk_bf16(b[0], b[1]); w.w = cvt_pk_bf16(b[2], b[3]);
            *(u32x4*)(ALR + (size_t)row * 1024 + (c0 - 1024)) = w;
        } else {
            u32x4 w; w.x = cvt_pk_bf16(x0[0], x0[1]); w.y = cvt_pk_bf16(x0[2], x0[3]); w.z = cvt_pk_bf16(x1[0], x1[1]); w.w = cvt_pk_bf16(x1[2], x1[3]);
            *(u32x4*)(G + (size_t)row * 1024 + (c0 - 2048)) = w;
        }
    }
    template <int I, int REG> __device__ __forceinline__ void rows(const f32x4 (&acc)[2][2][4][2], const int row0, const int cb) const {
        constexpr int ai = I >> 2, m = I & 3;
        const int row = row0 + ai * HALF + m * 16;
        if (row < MR) { one<REG>(acc[ai][0][m][0], acc[ai][0][m][1], row, cb); one<REG>(acc[ai][1][m][0], acc[ai][1][m][1], row, cb + HALF); }
    }
    template <int REG> __device__ __forceinline__ void all(const f32x4 (&acc)[2][2][4][2], const int row0, const int cb) const {
        rows<0, REG>(acc, row0, cb); rows<1, REG>(acc, row0, cb); rows<2, REG>(acc, row0, cb); rows<3, REG>(acc, row0, cb);
        rows<4, REG>(acc, row0, cb); rows<5, REG>(acc, row0, cb); rows<6, REG>(acc, row0, cb); rows<7, REG>(acc, row0, cb);
    }
    __device__ __forceinline__ void operator()(const f32x4 (&acc)[2][2][4][2], const Unit& u, int wr, int wc, int fr, int fq) const {
        const int row0 = u.pm * BM + wr * 64 + fr;
        const int cb = u.pn * BM + wc * 32 + 8 * fq;
        const int reg = __builtin_amdgcn_readfirstlane(u.pn >> 2);
        if (reg == 0) all<0>(acc, row0, cb); else if (reg == 1) all<1>(acc, row0, cb); else all<2>(acc, row0, cb);
    }
};

struct EpiRes {
    static constexpr bool PERM = true, AFTER_DRAIN = false;
    const float* basep; const bf16_t* baseh; float* Z; float* slab; int KC;
    __device__ __forceinline__ void operator()(const f32x4 (&acc)[2][2][4][2], const Unit& u, int wr, int wc, int fr, int fq) const {
        if (u.smp) {
            float* sp = slab + (size_t)(u.k0 / KC) * (128 * DM) + (size_t)(wr * 64 + fr) * DM + u.pn * BM + wc * 32 + 8 * fq;
#pragma unroll
            for (int m = 0; m < 4; ++m)
#pragma unroll
                for (int bj = 0; bj < 2; ++bj) { *(f32x4*)(sp + (size_t)m * 16 * DM + bj * HALF) = acc[0][bj][m][0]; *(f32x4*)(sp + (size_t)m * 16 * DM + bj * HALF + 4) = acc[0][bj][m][1]; }
            return;
        }
        const int row0 = u.pm * BM + wr * 64 + fr;
#pragma unroll
        for (int ai = 0; ai < 2; ++ai)
#pragma unroll
            for (int m = 0; m < 4; ++m) {
                const int row = row0 + ai * HALF + m * 16;
                const float* bp = basep + (size_t)row * DM;
                float* zp = Z + (size_t)row * DM;
#pragma unroll
                for (int bj = 0; bj < 2; ++bj) {
                    const int c0 = u.pn * BM + bj * HALF + wc * 32 + 8 * fq;
                    f32x4 x0, x1;
                    if (basep) { x0 = *(const f32x4*)(bp + c0); x1 = *(const f32x4*)(bp + c0 + 4); }
                    else { const u32x4 hb = *(const u32x4*)(baseh + (size_t)row * DM + c0); x0 = (f32x4){bflo(hb.x), bfhi(hb.x), bflo(hb.y), bfhi(hb.y)}; x1 = (f32x4){bflo(hb.z), bfhi(hb.z), bflo(hb.w), bfhi(hb.w)}; }
                    *(f32x4*)(zp + c0) = x0 * ALPHA_RES + acc[ai][bj][m][0]; *(f32x4*)(zp + c0 + 4) = x1 * ALPHA_RES + acc[ai][bj][m][1];
                }
            }
    }
};

struct EpiUp {
    static constexpr bool PERM = true, AFTER_DRAIN = false;
    bf16_t* U;
    __device__ __forceinline__ void operator()(const f32x4 (&acc)[2][2][4][2], const Unit& u, int wr, int wc, int fr, int fq) const {
        const int row0 = u.pm * BM + wr * 64 + fr;
#pragma unroll
        for (int ai = 0; ai < 2; ++ai)
#pragma unroll
            for (int m = 0; m < 4; ++m) {
                bf16_t* rowp = U + (size_t)(row0 + ai * HALF + m * 16) * DFF + u.pn * BM + wc * 32 + 8 * fq;
#pragma unroll
                for (int bj = 0; bj < 2; ++bj) {
                    f32x4 v0 = acc[ai][bj][m][0], v1 = acc[ai][bj][m][1];
#pragma unroll
                    for (int j = 0; j < 4; ++j) { const float a = fmaxf(v0[j], 0.f), b = fmaxf(v1[j], 0.f); v0[j] = a * a; v1[j] = b * b; }
                    u32x4 w; w.x = cvt_pk_bf16(v0[0], v0[1]); w.y = cvt_pk_bf16(v0[2], v0[3]); w.z = cvt_pk_bf16(v1[0], v1[1]); w.w = cvt_pk_bf16(v1[2], v1[3]);
                    *(u32x4*)(rowp + bj * HALF) = w;
                }
            }
    }
};

__device__ __forceinline__ float wave_sum(float v) {
#pragma unroll
    for (int o = 1; o < 64; o <<= 1) v += __shfl_xor(v, o);
    return v;
}
__device__ __forceinline__ float wave_max(float v) {
#pragma unroll
    for (int o = 1; o < 64; o <<= 1) v = fmaxf(v, __shfl_xor(v, o));
    return v;
}
__device__ __forceinline__ float red32(float v) {
#pragma unroll
    for (int o = 1; o < 32; o <<= 1) v += __shfl_xor(v, o);
    return v;
}
template <int CTRL> __device__ __forceinline__ float dpp_add(float x) {
    return x + __builtin_bit_cast(float, __builtin_amdgcn_update_dpp(0, __builtin_bit_cast(int, x), CTRL, 0xf, 0xf, false));
}
__device__ __forceinline__ float row16_sum(float x) {
    x = dpp_add<0xB1>(x); x = dpp_add<0x4E>(x); x = dpp_add<0x141>(x); x = dpp_add<0x140>(x); return x;
}

__device__ __forceinline__ void p0_transpose_item(const float* __restrict__ W, int K, int N, bf16_t* __restrict__ WT, LAS float* scr, int item, int lane) {
    const int nblk = (N + 31) >> 5, kb = item / nblk, nb = item - kb * nblk, k0 = 64 * kb, n0 = 32 * nb;
    const int kr = lane >> 3, n4 = (lane & 7) * 4; const bool ok = (n0 + n4) < N;
    f32x4 v[8];
#pragma unroll
    for (int i = 0; i < 8; ++i) v[i] = ok ? *(const f32x4*)(W + (size_t)(k0 + kr + 8 * i) * N + n0 + n4) : (f32x4){0.f, 0.f, 0.f, 0.f};
#pragma unroll
    for (int i = 0; i < 8; ++i) { LAS float* d = scr + (kr + 8 * i) * 33 + n4; d[0] = v[i][0]; d[1] = v[i][1]; d[2] = v[i][2]; d[3] = v[i][3]; }
    LDS_WAIT();
    const int c = lane & 7;
#pragma unroll
    for (int j = 0; j < 4; ++j) { const int n = (lane >> 3) + 8 * j; const LAS float* s = scr + (8 * c) * 33 + n;
        u32x4 o; o.x = pk2(s[0 * 33], s[1 * 33]); o.y = pk2(s[2 * 33], s[3 * 33]); o.z = pk2(s[4 * 33], s[5 * 33]); o.w = pk2(s[6 * 33], s[7 * 33]);
        *(u32x4*)(WT + (size_t)(n0 + n) * K + k0 + 8 * c) = o; }
    LDS_WAIT();
}
constexpr int I_IN = (DM / 64) * ((PTOT + 31) / 32), I_O = (DM / 64) * (DM / 32), I_UP = (DM / 64) * (DFF / 32), I_DN = (DFF / 64) * (DM / 32);
__device__ __forceinline__ void late_transpose_item(const Args& a, LAS float* scr, int r, int lane) {
    unsigned char* ws = a.ws;
    if (r < I_O) { p0_transpose_item(a.in[21], DM, DM, (bf16_t*)(ws + WS_WO), scr, r, lane); return; } r -= I_O;
    if (r < I_UP) { p0_transpose_item(a.in[24], DM, DFF, (bf16_t*)(ws + WS_WUP), scr, r, lane); return; } r -= I_UP;
    if (r < I_DN) p0_transpose_item(a.in[25], DFF, DM, (bf16_t*)(ws + WS_WDN), scr, r, lane);
}

__device__ __forceinline__ void late_item_desc(const Args& a, int r, const float*& W, bf16_t*& WT, int& K, int& N, int& ri) {
    unsigned char* ws = a.ws;
    if (r < I_O) { W = a.in[21]; WT = (bf16_t*)(ws + WS_WO); K = DM; N = DM; ri = r; }
    else if (r < I_O + I_UP) { W = a.in[24]; WT = (bf16_t*)(ws + WS_WUP); K = DM; N = DFF; ri = r - I_O; }
    else { W = a.in[25]; WT = (bf16_t*)(ws + WS_WDN); K = DFF; N = DM; ri = r - I_O - I_UP; }
}
__device__ __forceinline__ void late_item_load(const Args& a, int r, int lane, f32x4 (&v)[8]) {
    const float* W; bf16_t* WT; int K, N, ri; late_item_desc(a, r, W, WT, K, N, ri);
    const int nblk = N >> 5, kb = ri / nblk, nb = ri - kb * nblk, k0 = 64 * kb, n0 = 32 * nb, kr = lane >> 3, n4 = (lane & 7) * 4;
#pragma unroll
    for (int i = 0; i < 8; ++i) v[i] = *(const f32x4*)(W + (size_t)(k0 + kr + 8 * i) * N + n0 + n4);
}
__device__ __forceinline__ void late_item_finish(const Args& a, int r, int lane, const f32x4 (&v)[8], LAS float* scr) {
    const float* W; bf16_t* WT; int K, N, ri; late_item_desc(a, r, W, WT, K, N, ri);
    const int nblk = N >> 5, kb = ri / nblk, nb = ri - kb * nblk, k0 = 64 * kb, n0 = 32 * nb, kr = lane >> 3, n4 = (lane & 7) * 4;
#pragma unroll
    for (int i = 0; i < 8; ++i) { LAS float* d = scr + (kr + 8 * i) * 33 + n4; d[0] = v[i][0]; d[1] = v[i][1]; d[2] = v[i][2]; d[3] = v[i][3]; }
    LDS_WAIT();
    const int c = lane & 7;
#pragma unroll
    for (int j = 0; j < 4; ++j) { const int n = (lane >> 3) + 8 * j; const LAS float* s = scr + (8 * c) * 33 + n;
        u32x4 o; o.x = pk2(s[0 * 33], s[1 * 33]); o.y = pk2(s[2 * 33], s[3 * 33]); o.z = pk2(s[4 * 33], s[5 * 33]); o.w = pk2(s[6 * 33], s[7 * 33]);
        *(u32x4*)(WT + (size_t)(n0 + n) * K + k0 + 8 * c) = o; }
    LDS_WAIT();
}

__device__ __forceinline__ void phase0(const Args& a, LAS unsigned char* lds) {
    const int tid = threadIdx.x, lane = tid & 63, wave = tid >> 6, G = gridDim.x;
    unsigned char* ws = a.ws;
    if (blockIdx.x == 0 && tid < 256) ((unsigned*)(ws + WS_CTL))[tid] = 0u;
    LAS float* scr = (LAS float*)(lds + wave * 16384);
    const int gw = blockIdx.x * 8 + wave, NGW = G * 8;
    for (int it = gw; it < I_IN; it += NGW) p0_transpose_item(a.in[7], DM, PTOT, (bf16_t*)(ws + WS_WIN), scr, it, lane);
    const int gt = blockIdx.x * 512 + tid, NT = G * 512;
    { bf16_t* XB = (bf16_t*)(ws + WS_XB);
      for (int i = gt; i < MT * 256; i += NT) { const int row = i >> 8, c8 = (i & 255) * 8;
          u32x4 o = (u32x4){0u, 0u, 0u, 0u};
          if (row < MR) { const float* src = (row < MP) ? a.in[0] + (size_t)row * DM + c8 : a.in[1] + (size_t)(row - MP) * DM + c8;
              const f32x4 x0 = *(const f32x4*)src, x1 = *(const f32x4*)(src + 4);
              o.x = pk2(x0[0], x0[1]); o.y = pk2(x0[2], x0[3]); o.z = pk2(x1[0], x1[1]); o.w = pk2(x1[2], x1[3]); }
          *(u32x4*)(XB + (size_t)row * DM + c8) = o; } }
    { bf16_t* LT = (bf16_t*)(ws + WS_LORA);
      const float* w2 = a.in[10]; const float* a2 = a.in[12]; const float* g2 = a.in[13];
      for (int i = gt; i < NL * KL; i += NT) { const int n = i / KL, c = i - n * KL; float v = 0.f;
          if (n < 1024) { if (c < 64) v = w2[c * 1024 + n]; }
          else if (n < 2048) { if (c >= 64 && c < 128) v = a2[(c - 64) * 1024 + (n - 1024)]; }
          else { if (c >= 128 && c < 288) v = g2[(c - 128) * 1024 + (n - 2048)]; }
          LT[i] = (bf16_t)f2bf(v); } }
}

__device__ __forceinline__ void phase2(const Args& a) {
    const int tid = threadIdx.x, lane = tid & 63, wave = tid >> 6, G = gridDim.x;
    unsigned char* ws = a.ws;
    const bf16_t* PR = (const bf16_t*)(ws + WS_PR); bf16_t* LIN = (bf16_t*)(ws + WS_LIN);
    const float* mu = a.in[8]; const float* sshift = a.in[6];
    const int gt = blockIdx.x * 512 + tid, NT = G * 512;
    for (int i = gt; i < MT * (KL / 2); i += NT) {
        const int row = i / (KL / 2), j = (i - row * (KL / 2)) * 2;
        unsigned o = 0u;
        if (row < MR && j < 288) {
            const int col = 3072 + j;
            const unsigned pc = *(const unsigned*)(PR + (size_t)row * RPROJ + col);
            const float p0 = bflo(pc), p1 = bfhi(pc);
            float q0 = 0.f, q1 = 0.f;
            const int t = (row < MP) ? (row & (TP - 1)) : ((row - MP) & 15);
            if (t > 0) { const unsigned pp = *(const unsigned*)(PR + (size_t)(row - 1) * RPROJ + col); q0 = bflo(pp); q1 = bfhi(pp); }
            else if (row >= MP) { const float* s = sshift + (size_t)((row - MP) >> 4) * RPROJ + col; q0 = s[0]; q1 = s[1]; }
            const float x0 = p0 + (q0 - p0) * mu[col], x1 = p1 + (q1 - p1) * mu[col + 1];
            float f0, f1;
            if (j < 64) { f0 = tanhf(x0); f1 = tanhf(x1); } else if (j < 128) { f0 = x0; f1 = x1; } else { f0 = sigmoidf_(x0); f1 = sigmoidf_(x1); }
            o = pk2(f0, f1);
        }
        *(unsigned*)(LIN + (size_t)row * KL + j) = o;
    }
    const int gw = blockIdx.x * 8 + wave;
    if (gw < 32) {
        const int b = gw >> 4, h = gw & 15, t0 = lane * 64;
        const float* lf = a.out + OFF_PLOGF + ((size_t)b * TP + t0) * 16 + h;
        float loc = 0.f;
        for (int i = 0; i < 64; ++i) loc += lf[i * 16];
        float inc = loc;
#pragma unroll
        for (int o = 1; o < 64; o <<= 1) { const float n = __shfl_up(inc, o); if (lane >= o) inc += n; }
        float run = inc - loc;
        bf16_t* KE = (bf16_t*)(ws + WS_KE) + ((size_t)gw * TP + t0) * 4;
        for (int i = 0; i < 64; ++i) {
            run += lf[i * 16];
            const float kb = -run * LOG2E;
            const unsigned hi = f2bf(kb); const float r1 = kb - bf2f(hi);
            const unsigned mid = f2bf(r1); const float r2 = r1 - bf2f(mid);
            const unsigned lo = f2bf(r2);
            u32x2 o; o.x = hi | (mid << 16); o.y = lo;
            *(u32x2*)(KE + i * 4) = o;
        }
    }
}

__device__ __forceinline__ void ln_phase(float* Z, const float* g, const float* bta, bf16_t* HB, const float* sbase, const float* slab, const int nslab) {
    const int tid = threadIdx.x, lane = tid & 63, wave = tid >> 6;
    const int gw = blockIdx.x * 8 + wave, NGW = gridDim.x * 8;
    for (int it = gw; it < MT; it += NGW) {
        const int row = (it < 128) ? MP + it : (it < MR ? it - 128 : it);
        if (row >= MR) { if (HB) { u32x4* o = (u32x4*)(HB + (size_t)row * DM); for (int j = 0; j < 4; ++j) o[64 * j + lane] = (u32x4){0u, 0u, 0u, 0u}; } continue; }
        f32x4* zr = (f32x4*)(Z + (size_t)row * DM);
        f32x4 v[8]; float s = 0.f;
        if (row < MP) {
#pragma unroll
            for (int j = 0; j < 8; ++j) v[j] = zr[64 * j + lane];
        } else {
            const f32x4* br = (const f32x4*)(sbase + (size_t)(row - MP) * DM);
#pragma unroll
            for (int j = 0; j < 8; ++j) v[j] = br[64 * j + lane] * ALPHA_RES;
            for (int k = 0; k < nslab; ++k) { const f32x4* sr = (const f32x4*)(slab + ((size_t)k * 128 + (row - MP)) * DM);
#pragma unroll
                for (int j = 0; j < 8; ++j) v[j] += sr[64 * j + lane]; }
        }
#pragma unroll
        for (int j = 0; j < 8; ++j) s += (v[j][0] + v[j][1]) + (v[j][2] + v[j][3]);
        const float mean = wave_sum(s) * (1.f / DM); float s2 = 0.f;
#pragma unroll
        for (int j = 0; j < 8; ++j) { v[j] = v[j] - mean; s2 += (v[j][0] * v[j][0] + v[j][1] * v[j][1]) + (v[j][2] * v[j][2] + v[j][3] * v[j][3]); }
        const float rstd = rsqrtf(wave_sum(s2) * (1.f / DM) + 1e-5f);
#pragma unroll
        for (int j = 0; j < 8; ++j) {
            const f32x4 gg = ((const f32x4*)g)[64 * j + lane], bb = ((const f32x4*)bta)[64 * j + lane];
            const f32x4 y = v[j] * rstd * gg + bb;
            if (!HB || row >= MP) zr[64 * j + lane] = y;
            if (HB) { u32x2 o; o.x = pk2(y[0], y[1]); o.y = pk2(y[2], y[3]); *(u32x2*)(HB + (size_t)row * DM + (64 * j + lane) * 4) = o; }
        }
    }
}

__device__ __forceinline__ float row32_sum(float x) {
    x = row16_sum(x);
    float xa = x, xb = x;
    asm volatile("s_nop 1\n\tv_permlane32_swap_b32 %0, %1" : "+v"(xa), "+v"(xb));
    return xa + xb;
}
__device__ __forceinline__ float half32_sum(float x) {
    x = row16_sum(x);
    return x + __shfl_xor(x, 16);
}
template <bool SAMPLE>
__device__ __forceinline__ void scan_unit(const Args& a, unsigned char* lds, int b, int h, int qt, int sbi) {
    constexpr int TC = SAMPLE ? 16 : 32, NCH = SAMPLE ? 1 : (TP / 32), NS = TC / 8;
    const int tid = threadIdx.x, lane = tid & 63, w = __builtin_amdgcn_readfirstlane(tid >> 6);
    const size_t rowbase = SAMPLE ? (size_t)(MP + b * 16) : (size_t)b * TP;
    unsigned char* ws = a.ws;
    float* buf = (float*)lds;
    if (w < 4) {
        const int s = lane & 15, row = qt * 16 + w * 4 + (lane >> 4);
        bf16_t* YM = (bf16_t*)(ws + WS_YMIX) + rowbase * DM + h * 64 + row;
        typedef float f32x2 __attribute__((ext_vector_type(2)));
        f32x2 S01 = (f32x2){0.f, 0.f}, S23 = (f32x2){0.f, 0.f};
        if (SAMPLE) { const f32x4 x = *(const f32x4*)(a.in[5] + ((size_t)(b * 16 + h) * 64 + row) * 64 + 4 * s); S01 = x.lo; S23 = x.hi; }
        __syncthreads();
        for (int n = 0; n < NCH; ++n) {
            const float* bb = buf + (n & 1) * (TC * 384);
#pragma unroll 1
            for (int hf = 0; hf < TC / 16; ++hf) {
                float yk = 0.f;
#pragma unroll 8
                for (int st = 0; st < 16; ++st) {
                    const float* p = bb + (hf * 16 + st) * 384;
                    const f32x4 w4 = *(const f32x4*)(p + 4 * s), kh4 = *(const f32x4*)(p + 64 + 4 * s), a4 = *(const f32x4*)(p + 128 + 4 * s), b4 = *(const f32x4*)(p + 192 + 4 * s), r4 = *(const f32x4*)(p + 256 + 4 * s);
                    const float v = p[320 + row];
                    const f32x2 vv = (f32x2){v, v};
                    const f32x2 pv = S01 * a4.lo + S23 * a4.hi;
                    const f32x2 u01 = S01 * w4.lo + vv * kh4.lo, u23 = S23 * w4.hi + vv * kh4.hi;
                    const float sa = row16_sum(pv.x + pv.y);
                    const f32x2 sv = (f32x2){sa, sa};
                    S01 = sv * b4.lo + u01; S23 = sv * b4.hi + u23;
                    const f32x2 qv = S01 * r4.lo + S23 * r4.hi;
                    const float y = row16_sum(qv.x + qv.y);
                    yk = (s == st) ? y : yk;
                }
                YM[((size_t)n * TC + hf * 16 + s) * DM] = (bf16_t)f2bf(yk);
            }
            __syncthreads();
        }
        *(f32x4*)(a.out + (SAMPLE ? OFF_SWKV : OFF_PWKV) + ((size_t)(b * 16 + h) * 64 + row) * 64 + 4 * s) = (f32x4){S01.x, S01.y, S23.x, S23.y};
    } else {
        const bf16_t* PR = (const bf16_t*)(ws + WS_PR); const float* Wd = (const float*)(ws + WS_W); const bf16_t* ALR = (const bf16_t*)(ws + WS_ALR);
        const int ptid = tid - 256, pst = ptid >> 5, cp = ptid & 31, ch = h * 64 + 2 * cp;
        const float mur0 = a.in[8][ch], mur1 = a.in[8][ch + 1], muk0 = a.in[8][1024 + ch], muk1 = a.in[8][1025 + ch], muv0 = a.in[8][2048 + ch], muv1 = a.in[8][2049 + ch];
        const float kk0 = a.in[14][ch], kk1 = a.in[14][ch + 1], ka0 = a.in[15][ch], ka1 = a.in[15][ch + 1], rk0 = a.in[16][ch], rk1 = a.in[16][ch + 1];
        bf16_t* BV = (bf16_t*)a.out;
        unsigned rc[NS], kc[NS], vc[NS], rp[NS], kp[NS], vp[NS], al[NS]; float w0[NS], w1[NS];
#define SCAN_LOAD(n) do { _Pragma("unroll") for (int i_ = 0; i_ < NS; ++i_) { const int st_ = pst + 8 * i_; const size_t row_ = rowbase + (size_t)(n) * TC + st_; const bf16_t* pr_ = PR + row_ * RPROJ + ch; \
        rc[i_] = *(const unsigned*)pr_; kc[i_] = *(const unsigned*)(pr_ + 1024); vc[i_] = *(const unsigned*)(pr_ + 2048); \
        if ((n) > 0 || st_ > 0) { rp[i_] = *(const unsigned*)(pr_ - RPROJ); kp[i_] = *(const unsigned*)(pr_ - RPROJ + 1024); vp[i_] = *(const unsigned*)(pr_ - RPROJ + 2048); } else { rp[i_] = 0u; kp[i_] = 0u; vp[i_] = 0u; } \
        { const float* wp_ = Wd + row_ * 1024 + ch; w0[i_] = wp_[0]; w1[i_] = wp_[1]; } al[i_] = *(const unsigned*)(ALR + row_ * 1024 + ch); } } while (0)
#define SCAN_PREP(n) do { _Pragma("unroll") for (int i_ = 0; i_ < NS; ++i_) { const int st_ = pst + 8 * i_; float* bb_ = buf + ((n) & 1) * (TC * 384) + st_ * 384; \
        const float r0_ = bflo(rc[i_]), r1_ = bfhi(rc[i_]), k0_ = bflo(kc[i_]), k1_ = bfhi(kc[i_]), v0_ = bflo(vc[i_]), v1_ = bfhi(vc[i_]); \
        float rq0 = bflo(rp[i_]), rq1 = bfhi(rp[i_]), kq0 = bflo(kp[i_]), kq1 = bfhi(kp[i_]), vq0 = bflo(vp[i_]), vq1 = bfhi(vp[i_]); \
        if (SAMPLE && (n) == 0 && st_ == 0) { const float* sh_ = a.in[6] + (size_t)b * RPROJ + ch; rq0 = sh_[0]; rq1 = sh_[1]; kq0 = sh_[1024]; kq1 = sh_[1025]; vq0 = sh_[2048]; vq1 = sh_[2049]; } \
        const float rs0 = r0_ + (rq0 - r0_) * mur0, rs1 = r1_ + (rq1 - r1_) * mur1, ks0 = k0_ + (kq0 - k0_) * muk0, ks1 = k1_ + (kq1 - k1_) * muk1; \
        const float vs0 = v0_ + (vq0 - v0_) * muv0, vs1 = v1_ + (vq1 - v1_) * muv1; \
        const float n0_ = ks0 * kk0, n1_ = ks1 * kk1; const float ss_ = half32_sum(n0_ * n0_ + n1_ * n1_); const float inv_ = 1.0f / fmaxf(sqrtf(ss_), 1e-12f); \
        const float kn0 = n0_ * inv_, kn1 = n1_ * inv_, al0 = bflo(al[i_]), al1 = bfhi(al[i_]); \
        const float kh0 = ks0 * (1.0f + (al0 - 1.0f) * ka0), kh1 = ks1 * (1.0f + (al1 - 1.0f) * ka1); \
        { const float bo_ = half32_sum(rs0 * kh0 * rk0 + rs1 * kh1 * rk1); if ((cp >> 3) == qt) *(unsigned*)(BV + (rowbase + (size_t)(n) * TC + st_) * 1024 + ch) = pk2(bo_ * vs0, bo_ * vs1); } \
        *(float2*)(bb_ + 2 * cp) = make_float2(w0[i_], w1[i_]); *(float2*)(bb_ + 64 + 2 * cp) = make_float2(kh0, kh1); *(float2*)(bb_ + 128 + 2 * cp) = make_float2(-kn0, -kn1); \
        *(float2*)(bb_ + 192 + 2 * cp) = make_float2(kn0 * al0, kn1 * al1); *(float2*)(bb_ + 256 + 2 * cp) = make_float2(rs0, rs1); *(float2*)(bb_ + 320 + 2 * cp) = make_float2(vs0, vs1); } } while (0)
        SCAN_LOAD(0); SCAN_PREP(0);
        if (NCH > 1) SCAN_LOAD(1);
        LAS float* tscr = (LAS float*)((LAS unsigned char*)lds + 98304 + (w - 4) * 8448);
        f32x4 tv[8]; int tit = -1; const int pw = sbi * 4 + (w - 4);
        __syncthreads();
        for (int n = 0; n < NCH; ++n) {
            if (!SAMPLE && tit >= 0) late_item_finish(a, tit, lane, tv, tscr);
            if (!SAMPLE) { tit = pw + 512 * n; if (tit < I_O + I_UP + I_DN) late_item_load(a, tit, lane, tv); else tit = -1; }
            if (n + 1 < NCH) { SCAN_PREP(n + 1); if (n + 2 < NCH) SCAN_LOAD(n + 2); }
            __syncthreads();
        }
        if (!SAMPLE && tit >= 0) late_item_finish(a, tit, lane, tv, tscr);
#undef SCAN_LOAD
#undef SCAN_PREP
    }
}

__device__ __forceinline__ void phase_gn(const Args& a) {
    const int tid = threadIdx.x, lane = tid & 63, wave = tid >> 6;
    const int gw = blockIdx.x * 8 + wave, NGW = gridDim.x * 8;
    unsigned char* ws = a.ws;
    const bf16_t* Gt = (const bf16_t*)(ws + WS_G); bf16_t* YM = (bf16_t*)(ws + WS_YMIX); const bf16_t* BV = (const bf16_t*)a.out;
    for (int item = gw; item < MR * 16; item += NGW) {
        const int row = item >> 4, h = item & 15, ch = h * 64 + lane;
        const float y = bf2f(YM[(size_t)row * DM + ch]);
        const float bv = bf2f(BV[(size_t)row * 1024 + ch]), g = bf2f(Gt[(size_t)row * 1024 + ch]);
        const float mean = wave_sum(y) * (1.f / 64.f); const float d = y - mean;
        const float var = wave_sum(d * d) * (1.f / 64.f); const float rstd = rsqrtf(var + 64e-5f);
        const float o = (d * rstd * a.in[17][ch] + a.in[18][ch] + bv) * g;
        YM[(size_t)row * DM + ch] = (bf16_t)f2bf(o);
    }
}

__device__ __forceinline__ int crow(int r, int hi) { return (r & 3) + 8 * (r >> 2) + 4 * hi; }
__device__ __forceinline__ void attn_unit(const Args& a, unsigned char* lds, int bh, int qb) {
    const int tid = threadIdx.x, lane = tid & 63, w = tid >> 6, r32 = lane & 31, hi = lane >> 5;
    const int b = bh >> 4, h = bh & 15;
    unsigned char* ws = a.ws;
    const bf16_t* Q = (const bf16_t*)(ws + WS_Q); const bf16_t* KB = (const bf16_t*)(ws + WS_KB); const bf16_t* VT = (const bf16_t*)(ws + WS_VT);
    const bf16_t* KE = (const bf16_t*)(ws + WS_KE); const bf16_t* OG = (const bf16_t*)(ws + WS_OG); bf16_t* YM = (bf16_t*)(ws + WS_YMIX);
    bf16_t* Kt = (bf16_t*)lds;
    bf16_t* Vt = (bf16_t*)(lds + 18432);
    bf16_t* Et = (bf16_t*)(lds + 18432 + 17408);
    const size_t tokbase = (size_t)b * TP;
    const int q0 = qb * 256 + w * 32;
    bf16x8 qf[4];
    { const bf16_t* qp = Q + (tokbase + q0 + r32) * 1024 + h * 64 + hi * 8;
#pragma unroll
      for (int s = 0; s < 4; ++s) qf[s] = *(const bf16x8*)(qp + 16 * s); }
    bf16x8 qx = (bf16x8){0, 0, 0, 0, 0, 0, 0, 0};
    if (hi == 0) { qx[0] = (short)0x3F80; qx[1] = (short)0x3F80; qx[2] = (short)0x3F80; }
    f32x16 ot0, ot1;
#pragma unroll
    for (int r = 0; r < 16; ++r) { ot0[r] = 0.f; ot1[r] = 0.f; }
    float mrun = -INFINITY, lrun = 0.f;
    const int NT = 4 * (qb + 1);
    const int srow = tid >> 3, sch = tid & 7;
    const bf16_t* kg = KB + (tokbase + srow) * 1024 + h * 64 + sch * 8;
    const bf16_t* vg = VT + ((size_t)bh * 64 + srow) * TP + sch * 8;
    const bf16_t* eg = KE + ((size_t)bh * TP + (tid & 63)) * 4;
    u32x4 kreg, vreg; u32x2 ereg = (u32x2){0u, 0u};
#define ATT_LOAD(t) do { kreg = *(const u32x4*)(kg + (size_t)(t) * 64 * 1024); vreg = *(const u32x4*)(vg + (t) * 64); if (tid < 64) ereg = *(const u32x2*)(eg + (t) * 64 * 4); } while (0)
#define ATT_WRITE(bufi) do { *(u32x4*)(Kt + (bufi) * 4608 + srow * 72 + sch * 8) = kreg; \
        *(u32x2*)(Vt + (bufi) * 4352 + srow * 68 + sch * 8) = (u32x2){vreg.x, vreg.y}; *(u32x2*)(Vt + (bufi) * 4352 + srow * 68 + sch * 8 + 4) = (u32x2){vreg.z, vreg.w}; \
        if (tid < 64) *(u32x2*)(Et + (bufi) * 256 + tid * 4) = ereg; } while (0)
    ATT_LOAD(0); ATT_WRITE(0);
    __syncthreads();
    for (int t = 0; t < NT; ++t) {
        const int cur = t & 1;
        if (t + 1 < NT) ATT_LOAD(t + 1);
        if (64 * t <= q0 + 31) {
            const bf16_t* kb_ = Kt + cur * 4608; const bf16_t* vb_ = Vt + cur * 4352; const bf16_t* eb_ = Et + cur * 256;
            f32x16 st0, st1;
#pragma unroll
            for (int r = 0; r < 16; ++r) { st0[r] = 0.f; st1[r] = 0.f; }
#pragma unroll
            for (int s = 0; s < 4; ++s) {
                const bf16x8 k0 = *(const bf16x8*)(kb_ + r32 * 72 + 16 * s + 8 * hi), k1 = *(const bf16x8*)(kb_ + (32 + r32) * 72 + 16 * s + 8 * hi);
                st0 = __builtin_amdgcn_mfma_f32_32x32x16_bf16(k0, qf[s], st0, 0, 0, 0);
                st1 = __builtin_amdgcn_mfma_f32_32x32x16_bf16(k1, qf[s], st1, 0, 0, 0);
            }
            {
                bf16x8 e0 = (bf16x8){0, 0, 0, 0, 0, 0, 0, 0}, e1 = e0;
                if (hi == 0) {
                    const u32x2 x0 = *(const u32x2*)(eb_ + r32 * 4), x1 = *(const u32x2*)(eb_ + (32 + r32) * 4);
                    e0[0] = (short)(x0.x & 0xffffu); e0[1] = (short)(x0.x >> 16); e0[2] = (short)(x0.y & 0xffffu);
                    e1[0] = (short)(x1.x & 0xffffu); e1[1] = (short)(x1.x >> 16); e1[2] = (short)(x1.y & 0xffffu);
                }
                st0 = __builtin_amdgcn_mfma_f32_32x32x16_bf16(e0, qx, st0, 0, 0, 0);
                st1 = __builtin_amdgcn_mfma_f32_32x32x16_bf16(e1, qx, st1, 0, 0, 0);
            }
            if (64 * t + 63 > q0) {
                const int qi = q0 + r32;
#pragma unroll
                for (int r = 0; r < 16; ++r) { const int kv = 64 * t + crow(r, hi); if (kv > qi) st0[r] = -INFINITY; if (kv + 32 > qi) st1[r] = -INFINITY; }
            }
            float mx = fmaxf(st0[0], st1[0]);
#pragma unroll
            for (int r = 1; r < 16; ++r) mx = fmaxf(mx, fmaxf(st0[r], st1[r]));
            mx = fmaxf(mx, __shfl_xor(mx, 32));
            const float mnew = fmaxf(mrun, mx);
            const float alpha = __builtin_amdgcn_exp2f(mrun - mnew);
            mrun = mnew;
            float rs = 0.f;
#pragma unroll
            for (int r = 0; r < 16; ++r) { st0[r] = __builtin_amdgcn_exp2f(st0[r] - mnew); st1[r] = __builtin_amdgcn_exp2f(st1[r] - mnew); rs += st0[r] + st1[r]; }
            lrun = lrun * alpha + rs;
#pragma unroll
            for (int r = 0; r < 16; ++r) { ot0[r] *= alpha; ot1[r] *= alpha; }
#pragma unroll
            for (int sp = 0; sp < 4; ++sp) {
                const int base = 8 * (sp & 1);
                u32x4 pw;
                if (sp < 2) { pw.x = cvt_pk_bf16(st0[base + 0], st0[base + 1]); pw.y = cvt_pk_bf16(st0[base + 2], st0[base + 3]); pw.z = cvt_pk_bf16(st0[base + 4], st0[base + 5]); pw.w = cvt_pk_bf16(st0[base + 6], st0[base + 7]); }
                else        { pw.x = cvt_pk_bf16(st1[base + 0], st1[base + 1]); pw.y = cvt_pk_bf16(st1[base + 2], st1[base + 3]); pw.z = cvt_pk_bf16(st1[base + 4], st1[base + 5]); pw.w = cvt_pk_bf16(st1[base + 6], st1[base + 7]); }
                const bf16x8 pf = __builtin_bit_cast(bf16x8, pw);
                {
                    const bf16_t* vp = vb_ + r32 * 68 + 16 * sp + 4 * hi;
                    const u32x2 lo = *(const u32x2*)vp, hi2 = *(const u32x2*)(vp + 8);
                    const bf16x8 vf = __builtin_bit_cast(bf16x8, (u32x4){lo.x, lo.y, hi2.x, hi2.y});
                    ot0 = __builtin_amdgcn_mfma_f32_32x32x16_bf16(vf, pf, ot0, 0, 0, 0);
                }
                {
                    const bf16_t* vp = vb_ + (32 + r32) * 68 + 16 * sp + 4 * hi;
                    const u32x2 lo = *(const u32x2*)vp, hi2 = *(const u32x2*)(vp + 8);
                    const bf16x8 vf = __builtin_bit_cast(bf16x8, (u32x4){lo.x, lo.y, hi2.x, hi2.y});
                    ot1 = __builtin_amdgcn_mfma_f32_32x32x16_bf16(vf, pf, ot1, 0, 0, 0);
                }
            }
        }
        if (t + 1 < NT) ATT_WRITE(cur ^ 1);
        __syncthreads();
    }
#undef ATT_LOAD
#undef ATT_WRITE
    {
        const float lt = lrun + __shfl_xor(lrun, 32); const float inv = 1.0f / lt;
        float ss = 0.f;
#pragma unroll
        for (int r = 0; r < 16; ++r) { ot0[r] *= inv; ot1[r] *= inv; ss += ot0[r] * ot0[r] + ot1[r] * ot1[r]; }
        ss += __shfl_xor(ss, 32);
        const float rinv = rsqrtf(ss * (1.f / 64.f) + 1e-6f);
        const size_t row = tokbase + q0 + r32;
        const float* fog = a.in[20];
#pragma unroll
        for (int dh = 0; dh < 2; ++dh)
#pragma unroll
            for (int g = 0; g < 4; ++g) {
                const int col = h * 64 + 32 * dh + 8 * g + 4 * hi;
                const u32x2 og = *(const u32x2*)(OG + row * 1024 + col); const f32x4 gg = *(const f32x4*)(fog + col);
                float o[4];
#pragma unroll
                for (int j = 0; j < 4; ++j) o[j] = (dh == 0 ? ot0[4 * g + j] : ot1[4 * g + j]) * rinv * gg[j];
                u32x2 wv; wv.x = pk2(o[0] * bflo(og.x), o[1] * bfhi(og.x)); wv.y = pk2(o[2] * bflo(og.y), o[3] * bfhi(og.y));
                *(u32x2*)(YM + row * DM + 1024 + col) = wv;
            }
    }
}

__device__ __forceinline__ void sattn_unit(const Args& a, unsigned char* lds, int bh) {
    const int tid = threadIdx.x, lane = tid & 63, w = tid >> 6;
    const int b = bh >> 4, h = bh & 15;
    unsigned char* ws = a.ws;
    const bf16_t* Q = (const bf16_t*)(ws + WS_Q); const bf16_t* OG = (const bf16_t*)(ws + WS_OG); bf16_t* YM = (bf16_t*)(ws + WS_YMIX);
    const float* ck = a.in[2]; const float* cv = a.in[3]; const float* clf = a.in[4];
    float* qs = (float*)lds;
    float* cb = qs + 1024;
    float* sc = cb + 1088;
    float* red = sc + 16640;
    for (int i = tid; i < 1024; i += 512) { const int q = i >> 6, d = i & 63; qs[i] = bf2f(Q[(size_t)(MP + b * 16 + q) * 1024 + h * 64 + d]); }
    if (w == 0) {
        const int e0 = lane * 17; float loc = 0.f;
        for (int i = 0; i < 17; ++i) { const int e = e0 + i; if (e < 1040) loc += (e < 1024) ? clf[((size_t)b * 1024 + e) * 16 + h] : a.out[OFF_SLOGF + (size_t)(b * 16 + e - 1024) * 16 + h]; }
        float inc = loc;
#pragma unroll
        for (int o = 1; o < 64; o <<= 1) { const float n = __shfl_up(inc, o); if (lane >= o) inc += n; }
        float run = inc - loc;
        for (int i = 0; i < 17; ++i) { const int e = e0 + i; if (e < 1040) { run += (e < 1024) ? clf[((size_t)b * 1024 + e) * 16 + h] : a.out[OFF_SLOGF + (size_t)(b * 16 + e - 1024) * 16 + h]; cb[e] = -run * LOG2E; } }
    }
    __syncthreads();
#pragma unroll 1
    for (int it = 0; it < 3; ++it) {
        const int j = tid + 512 * it;
        if (j < 1040) {
            const float* kp = (j < 1024) ? ck + (((size_t)b * 1024 + j) * 16 + h) * 64 : a.out + OFF_SK + ((size_t)(b * 16 + j - 1024) * 16 + h) * 64;
            f32x4 kv[16];
#pragma unroll
            for (int i = 0; i < 16; ++i) kv[i] = *(const f32x4*)(kp + 4 * i);
            const float bias = cb[j];
#pragma unroll 1
            for (int q = 0; q < 16; ++q) {
                const f32x4* qp = (const f32x4*)(qs + q * 64);
                float d0 = 0.f, d1 = 0.f;
#pragma unroll
                for (int i = 0; i < 16; i += 2) { const f32x4 x = qp[i], y = qp[i + 1];
                    d0 += x[0] * kv[i][0] + x[1] * kv[i][1] + x[2] * kv[i][2] + x[3] * kv[i][3];
                    d1 += y[0] * kv[i + 1][0] + y[1] * kv[i + 1][1] + y[2] * kv[i + 1][2] + y[3] * kv[i + 1][3]; }
                float sv = d0 + d1 + bias;
                if (j >= 1024 && j - 1024 > q) sv = -INFINITY;
                sc[q * 1040 + j] = sv;
            }
        }
    }
    __syncthreads();
    for (int qq = 0; qq < 2; ++qq) {
        float* sr = sc + (2 * w + qq) * 1040;
        float mx = -INFINITY;
        for (int j = lane; j < 1040; j += 64) mx = fmaxf(mx, sr[j]);
        mx = wave_max(mx);
        float sum = 0.f;
        for (int j = lane; j < 1040; j += 64) { const float p = __builtin_amdgcn_exp2f(sr[j] - mx); sr[j] = p; sum += p; }
        sum = wave_sum(sum);
        const float inv = 1.0f / sum;
        for (int j = lane; j < 1040; j += 64) sr[j] *= inv;
    }
    __syncthreads();
    {
        float acc[16];
#pragma unroll
        for (int q = 0; q < 16; ++q) acc[q] = 0.f;
        const float* vbase = cv + (((size_t)b * 1024) * 16 + h) * 64 + lane;
#pragma unroll 16
        for (int j = w; j < 1024; j += 8) {
            const float vv = vbase[(size_t)j * 1024];
#pragma unroll
            for (int q = 0; q < 16; ++q) acc[q] = fmaf(sc[q * 1040 + j], vv, acc[q]);
        }
        for (int j = 1024 + w; j < 1040; j += 8) {
            const float vv = a.out[OFF_SV + ((size_t)(b * 16 + j - 1024) * 16 + h) * 64 + lane];
#pragma unroll
            for (int q = 0; q < 16; ++q) acc[q] = fmaf(sc[q * 1040 + j], vv, acc[q]);
        }
#pragma unroll
        for (int q = 0; q < 16; ++q) red[(w * 16 + q) * 64 + lane] = acc[q];
    }
    __syncthreads();
    for (int pass = 0; pass < 2; ++pass) {
        const int q = w + 8 * pass;
        float o = 0.f;
#pragma unroll
        for (int ww = 0; ww < 8; ++ww) o += red[(ww * 16 + q) * 64 + lane];
        const float ss = wave_sum(o * o);
        const float rinv = rsqrtf(ss * (1.f / 64.f) + 1e-6f);
        const size_t row = (size_t)(MP + b * 16 + q); const int col = h * 64 + lane;
        const float y = o * rinv * a.in[20][col] * bf2f(OG[row * 1024 + col]);
        YM[row * DM + 1024 + col] = (bf16_t)f2bf(y);
    }
    __syncthreads();
}

__device__ __forceinline__ int next_work(unsigned* ctr, unsigned char* lds) {
    volatile unsigned* wordp = (volatile unsigned*)(lds + LDS_WORD_OFF);
    if (threadIdx.x == 0) *wordp = __hip_atomic_fetch_add(ctr, 1u, __ATOMIC_RELAXED, __HIP_MEMORY_SCOPE_AGENT);
    __syncthreads();
    const int v = (int)*wordp;
    __syncthreads();
    return v;
}

#define GAS __attribute__((address_space(1)))
#define RLX_AGENT __ATOMIC_RELAXED, __HIP_MEMORY_SCOPE_AGENT
#define XB_TMO      128
#define XB_XCNT(j)  (256  + 64 * (j))
#define XB_XSUB(j)  (1280 + 64 * (j))
#define XB_XGEN(j)  (2304 + 64 * (j))
#define XB_TOP      3328
#define XB_TOPGEN   3392
#define XCD_BAR_WORDS 3456
#define XB_SPIN_CAP (1u << 18)

__device__ __forceinline__ unsigned xb_ld(unsigned* p)              { return __hip_atomic_load(p, __ATOMIC_RELAXED, __HIP_MEMORY_SCOPE_AGENT); }
__device__ __forceinline__ unsigned xb_add(unsigned* p, unsigned v) { return __hip_atomic_fetch_add(p, v, __ATOMIC_RELAXED, __HIP_MEMORY_SCOPE_AGENT); }
__device__ __forceinline__ unsigned xb_xcc_id() { return (unsigned)__builtin_amdgcn_s_getreg((3 << 11) | 20) & 0xFu; }
#define XB_SPIN(cond, bar) do { unsigned _sp = 0; while (cond) { __builtin_amdgcn_s_sleep(1); \
    if ((++_sp & 255u) == 0u) { if (xb_ld(&(bar)[XB_TMO])) break; if (_sp > XB_SPIN_CAP) { atomicAdd(&(bar)[XB_TMO], 1u); break; } } } } while (0)

struct XcdBarrier {
    unsigned* bar; unsigned x;
    volatile LAS unsigned* st;
};

__device__ __forceinline__ XcdBarrier xcd_barrier_post(unsigned* bar, volatile LAS unsigned* st) {
    XcdBarrier b; b.bar = bar; b.x = xb_xcc_id(); b.st = st;
    if (threadIdx.x == 0) (void)xb_add(&bar[XB_XCNT(b.x)], 1u);
    return b;
}
__device__ __forceinline__ void xcd_barrier_complete(unsigned* bar, unsigned x, unsigned& nloc, unsigned& nx) {
    const unsigned G = gridDim.x * gridDim.y * gridDim.z;
    unsigned sum, cnt, mine, sp = 0u;
    for (;;) {
        sum = 0u; cnt = 0u; mine = 0u;
#pragma unroll
        for (unsigned j = 0; j < 16; ++j) { const unsigned c = xb_ld(&bar[XB_XCNT(j)]); sum += c; cnt += (c > 0u) ? 1u : 0u; mine = (j == x) ? c : mine; }
        if (sum == G) break;
        __builtin_amdgcn_s_sleep(1);
        if ((++sp & 255u) == 0u) { if (xb_ld(&bar[XB_TMO])) break; if (sp > XB_SPIN_CAP) { atomicAdd(&bar[XB_TMO], 1u); break; } }
    }
    nloc = mine > 0u ? mine : 1u; nx = cnt > 0u ? cnt : 1u;
}

__device__ __forceinline__ void xcd_barrier(const XcdBarrier& b) {
    asm volatile("s_waitcnt vmcnt(0)" ::: "memory");
    __syncthreads();
    if (threadIdx.x == 0) {
        unsigned* bar = b.bar;
        __builtin_amdgcn_s_waitcnt(0);
        unsigned nloc = b.st[0], nx = b.st[1];
        if (nloc == 0u) { xcd_barrier_complete(bar, b.x, nloc, nx); b.st[0] = nloc; b.st[1] = nx; }
        const unsigned old = xb_add(&bar[XB_XSUB(b.x)], 1u);
        const unsigned gen = old / nloc;
        if (old + 1u == (gen + 1u) * nloc) {
            __builtin_amdgcn_fence(__ATOMIC_RELEASE, "agent");
            asm volatile("s_waitcnt vmcnt(0)" ::: "memory");
            const unsigned og = xb_add(&bar[XB_TOP], 1u);
            const unsigned tg = og / nx;
            if (og + 1u == (tg + 1u) * nx) xb_add(&bar[XB_TOPGEN], 1u);
            else XB_SPIN(xb_ld(&bar[XB_TOPGEN]) == tg, bar);
            __builtin_amdgcn_fence(__ATOMIC_ACQUIRE, "agent");
            xb_add(&bar[XB_XGEN(b.x)], 1u);
            asm volatile("s_waitcnt vmcnt(0)" ::: "memory");
        } else {
            XB_SPIN(xb_ld(&bar[XB_XGEN(b.x)]) == gen, bar);
            __builtin_amdgcn_fence(__ATOMIC_ACQUIRE, "agent");
            asm volatile("s_waitcnt vmcnt(0)" ::: "memory");
        }
    }
    __syncthreads();
}

__global__ void __launch_bounds__(512, 2) mk_fwd(Args a) {
    extern __shared__ __attribute__((aligned(16))) unsigned char lds[];
    LAS unsigned char* ldsl = (LAS unsigned char*)lds;
    const int lo = a.ph_lo, hi = a.ph_hi, G = gridDim.x;
    unsigned char* ws = a.ws;
#ifndef PH_MASK
#define PH_MASK 0x7ff
#endif
#define IN(k) (((PH_MASK >> (k)) & 1) && lo <= (k) && (k) < hi)
    if (threadIdx.x < 4) ((LAS unsigned*)(ldsl + LDS_BARW_OFF))[threadIdx.x] = 0u;
    __syncthreads();
    XcdBarrier bar = xcd_barrier_post((unsigned*)(ws + WS_CTL) + CW_BAR, (volatile LAS unsigned*)(ldsl + LDS_BARW_OFF));
    if (a.ph_hi > 1000) cg::this_grid().sync();
#define SEAM(k) do { if (IN(k) && IN((k) + 1)) xcd_barrier(bar); } while (0)
    if (IN(0)) { phase0(a, ldsl); }
    SEAM(0);
    if (IN(1)) {
        Gemm g{(const bf16_t*)(ws + WS_XB), (const bf16_t*)(ws + WS_WIN), MT, NIN, DM}; StaticOrder S; S.init(MT, NIN, DM, G, (int)blockIdx.x);
        EpiIn E{(bf16_t*)(ws + WS_PR), (bf16_t*)(ws + WS_Q), (bf16_t*)(ws + WS_KB), (bf16_t*)(ws + WS_VT), (bf16_t*)(ws + WS_OG), a.out, a.in[19]};
        gemm_phase<EpiIn, StaticOrder, true, true>(ldsl, g, S, E);
    }
    SEAM(1);
    if (IN(2)) { phase2(a); }
    SEAM(2);
    if (IN(3)) {
        Gemm g{(const bf16_t*)(ws + WS_LIN), (const bf16_t*)(ws + WS_LORA), MT, NL, KL}; StaticOrder S; S.init(MT, NL, KL, G, (int)blockIdx.x);
        EpiLora E{(float*)(ws + WS_W), (bf16_t*)(ws + WS_ALR), (bf16_t*)(ws + WS_G), a.in[9], a.in[11]};
        gemm_phase<EpiLora, StaticOrder, true, true>(ldsl, g, S, E);
    }
    SEAM(3);
    if (IN(4)) {
        unsigned* ctr = (unsigned*)(ws + WS_CTL) + 128 * a.rep;
        const int pm_ = a.pad ? a.pad : 7;
        if (blockIdx.x < 128) { if (pm_ & 1) { const int sb = (int)blockIdx.x; const int bh = (sb & 7) * 4 + ((sb >> 3) >> 2); scan_unit<false>(a, lds, bh >> 4, bh & 15, (sb >> 3) & 3, sb); } }
        else if (pm_ & 2) { for (;;) { const int i = next_work(ctr, lds); if (i >= 512) break; attn_unit(a, lds, i & 31, 15 - (i >> 5)); } }
        if (pm_ & 4) for (;;) { const int j = next_work(ctr + 64, lds); if (j >= 640) break;
            if (j < 128) sattn_unit(a, lds, j); else { const int u = j - 128; scan_unit<true>(a, lds, u >> 6, (u >> 2) & 15, u & 3, 0); } }
    }
    SEAM(4);
    if (IN(5)) { phase_gn(a); }
    SEAM(5);
    if (IN(6)) {
        Gemm g{(const bf16_t*)(ws + WS_YMIX), (const bf16_t*)(ws + WS_WO), MT, DM, DM}; SplitOrder S; S.init(DM, DM, G, (int)blockIdx.x, 512);
        EpiRes E{a.in[0], nullptr, a.out, (float*)(ws + WS_SLAB1), 512};
        gemm_phase<EpiRes, SplitOrder, true, true>(ldsl, g, S, E);
    }
    SEAM(6);
    if (IN(7)) { ln_phase(a.out, a.in[22], a.in[23], (bf16_t*)(ws + WS_HB), a.in[1], (const float*)(ws + WS_SLAB1), 4); }
    SEAM(7);
    if (IN(8)) {
        Gemm g{(const bf16_t*)(ws + WS_HB), (const bf16_t*)(ws + WS_WUP), MT, DFF, DM}; StaticOrder S; S.init(MT, DFF, DM, G, (int)blockIdx.x);
        EpiUp E{(bf16_t*)(ws + WS_U)};
        gemm_phase<EpiUp, StaticOrder, true, true>(ldsl, g, S, E);
    }
    SEAM(8);
    if (IN(9)) {
        Gemm g{(const bf16_t*)(ws + WS_U), (const bf16_t*)(ws + WS_WDN), MT, DM, DFF}; SplitOrder S; S.init(DM, DFF, G, (int)blockIdx.x, 1024);
        EpiRes E{nullptr, (const bf16_t*)(ws + WS_HB), a.out, (float*)(ws + WS_SLAB2), 1024};
        gemm_phase<EpiRes, SplitOrder, true, true>(ldsl, g, S, E);
    }
    SEAM(9);
    if (IN(10)) { ln_phase(a.out, a.in[26], a.in[27], nullptr, a.out + OFF_YS, (const float*)(ws + WS_SLAB2), 8); }
#undef IN
#undef SEAM
}
}

extern "C" void kernel_launch(void* const* d_in, const int* in_sizes, int n_in, void* d_out, int out_size, void* d_ws, size_t ws_size, hipStream_t stream) {
    using namespace pg8;
    static int grid = 0;
    if (grid == 0) {
        if (n_in != 28 || (size_t)out_size != OUT_TOTAL || ws_size < WS_END) { fprintf(stderr, "kernel_launch: unexpected problem (n_in %d, out %d, ws %zu); nothing launched\n", n_in, out_size, ws_size); grid = -1; return; }
        int dev = 0, cus = 0, per_cu = 0;
        if (hipGetDevice(&dev) != hipSuccess || hipDeviceGetAttribute(&cus, hipDeviceAttributeMultiprocessorCount, dev) != hipSuccess) { grid = -1; return; }
        if (hipFuncSetAttribute((const void*)mk_fwd, hipFuncAttributeMaxDynamicSharedMemorySize, LDS_BYTES) != hipSuccess) { fprintf(stderr, "kernel_launch: hipFuncSetAttribute failed\n"); grid = -1; return; }
        if (hipOccupancyMaxActiveBlocksPerMultiprocessor(&per_cu, (const void*)mk_fwd, 512, LDS_BYTES) != hipSuccess || per_cu < 1) { fprintf(stderr, "kernel_launch: occupancy query says %d\n", per_cu); per_cu = 1; }
        (void)hipGetLastError();
        grid = cus;
    }
    if (grid < 0) return;
    if (hipMemsetAsync((char*)d_ws + WS_CTL, 0, 65536, stream) != hipSuccess) { fprintf(stderr, "kernel_launch: hipMemsetAsync failed\n"); return; }
    Args a{};
    for (int i = 0; i < 28; ++i) a.in[i] = (const float*)d_in[i];
    a.out = (float*)d_out; a.ws = (unsigned char*)d_ws;
#if ONE_LAUNCH
    a.ph_lo = 0; a.ph_hi = NPH;
    void* args[] = {&a};
    hipError_t e = hipLaunchCooperativeKernel((const void*)mk_fwd, dim3(grid), dim3(512), args, LDS_BYTES, stream);
    if (e != hipSuccess) fprintf(stderr, "kernel_launch: cooperative launch failed: %s (grid %d)\n", hipGetErrorString(e), grid);
#else
#ifndef PROBE_DUP
#define PROBE_DUP -1
#endif
#ifndef PROBE_MODE
#define PROBE_MODE 0
#endif
    for (int p = 0; p < NPH; ++p) { a.ph_lo = p; a.ph_hi = p + 1; a.rep = 0; a.pad = 0; hipLaunchKernelGGL(mk_fwd, dim3(grid), dim3(512), LDS_BYTES, stream, a);
        if (p == PROBE_DUP) { a.rep = 1; a.pad = PROBE_MODE; hipLaunchKernelGGL(mk_fwd, dim3(grid), dim3(512), LDS_BYTES, stream, a); } }
#endif
}
```

```cpp
#include <hip/hip_runtime.h>
#include <hip/hip_cooperative_groups.h>
#include <cstdio>
#include <cstdint>
namespace pg8 {
#define PG8_LAS __attribute__((address_space(3)))
typedef unsigned short bf16_t;
typedef short bf16x8 __attribute__((ext_vector_type(8)));
typedef float f32x4 __attribute__((ext_vector_type(4)));
typedef unsigned u32x4 __attribute__((ext_vector_type(4)));
constexpr int BM = 256, BK = 64, HALF = 128, HTB = HALF * BK * 2  , STAGE_BYTES = 8 * HTB, NXCD = 8, WGM = 8;

__host__ __device__ __forceinline__ int lds_byte(int r, int c) { const int st = (r >> 4) * 2 + (c >> 5), rr = r & 15, cc = c & 31, ob = rr * 64 + cc * 2; return st * 1024 + (ob ^ (((ob >> 9) & 1) << 5)); }
__host__ __device__ __forceinline__ void stage_rc(int b, int& R, int& C) { const int st = b / 1024, sb = b % 1024, swz = sb ^ (((sb >> 9) & 1) << 5); R = (st >> 1) * 16 + swz / 64; C = (st & 1) * 32 + (swz % 64) / 2; }
__host__ __device__ __forceinline__ int perm32(int rho) { const int n = rho >> 4, i = rho & 15; return 8 * (i >> 2) + 4 * n + (i & 3); }

struct Unit { int pm, pn, k0, nt, smp; };
struct Gemm { const bf16_t* A; const bf16_t* Bt; int M, N, K; };

struct StaticOrder {
    int nM, nN, nwg, G, c, ntk;
    __host__ __device__ void init(int M, int N, int K, int G_, int c_) { nM = M / BM; nN = N / BM; nwg = nM * nN; G = G_; c = c_; ntk = K / BK; }
    __host__ __device__ bool next(int i, Unit& u) const {
        const long L = (long)i * G + c; if (L >= nwg) return false;
        int wgid = (int)L; { const int q = nwg / NXCD, r = nwg % NXCD, xcd = wgid % NXCD, off = wgid / NXCD; wgid = (xcd < r ? xcd * (q + 1) : r * (q + 1) + (xcd - r) * q) + off; }
        const int nig = WGM * nN, gid = wgid / nig, fm = gid * WGM, gsz = (nM - fm) < WGM ? (nM - fm) : WGM;
        u.pm = fm + ((wgid % nig) % gsz); u.pn = (wgid % nig) / gsz; u.k0 = 0; u.nt = ntk; u.smp = 0; return true;
    }
    __device__ __forceinline__ void a_ready(const Unit&) const {}
    __device__ __forceinline__ void done(const Unit&) const {}
};

struct SplitOrder {
    StaticOrder P; int nN, nks, KC;
    __host__ __device__ void init(int N, int K, int G_, int c_, int KC_) { P.init(8192, N, K, G_, c_); nN = N / BM; KC = KC_; nks = K / KC_; }
    __host__ __device__ bool next(int i, Unit& u) const {
        const long L = (long)i * P.G + P.c;
        if (L < P.nwg) return P.next(i, u);
        const int idx = (int)(L - P.nwg); if (idx >= nN * nks) return false;
        u.pm = 32; u.pn = idx % nN; u.k0 = (idx / nN) * KC; u.nt = KC / BK; u.smp = 1; return true;
    }
    __device__ __forceinline__ void a_ready(const Unit&) const {}
    __device__ __forceinline__ void done(const Unit&) const {}
};

__device__ __forceinline__ unsigned cvt_pk_bf16(float lo, float hi) { unsigned r; asm volatile("v_cvt_pk_bf16_f32 %0, %1, %2" : "=v"(r) : "v"(lo), "v"(hi)); return r; }
template <class Epi, class Sched, bool ALIGN_EPI = false, bool SP2 = false>
__device__ __forceinline__ void gemm_phase(PG8_LAS unsigned char* lds, const Gemm g, const Sched& S, const Epi& E) {
    const int tid = threadIdx.x, wid = __builtin_amdgcn_readfirstlane(tid >> 6), lane = tid & 63, wr = wid >> 2, wc = wid & 3, fr = lane & 15, fq = lane >> 4;
    const int K = g.K;
    unsigned voffA[2], voffB[2];
#pragma unroll
    for (int i = 0; i < 2; ++i) { int R, C; stage_rc(tid * 16 + i * 8192, R, C); const int Rb = Epi::PERM ? ((R & ~31) + perm32(R & 31)) : R;
        voffA[i] = (unsigned)(R * K + C) * 2u; voffB[i] = (unsigned)(Rb * K + C) * 2u; }
    const size_t kstep = (size_t)(BK * 2);
    const size_t hstep = (size_t)HALF * K * 2;
    const size_t tstep = 2 * hstep;
    const unsigned ldsw = (unsigned)wid * 1024u;
    const int aoff = lds_byte(wr * 64 + fr, fq * 8), boff = lds_byte(wc * 32 + fr, fq * 8);
#define PG8_SA(b, h) (((b) * 2 + (h)) * HTB)
#define PG8_SB(b, h) ((4 + (b) * 2 + (h)) * HTB)
#define PG8_STAGE(bufoff, gbase, voff) do { _Pragma("unroll") for (int _i = 0; _i < 2; ++_i) \
        __builtin_amdgcn_global_load_lds((const unsigned*)((const char*)(gbase) + (voff)[_i]), (PG8_LAS unsigned*)(lds + (bufoff) + ldsw + _i * 8192), 16, 0, 0); } while (0)
#define PG8_LDA(dst, b, h) do { _Pragma("unroll") for (int m = 0; m < 4; ++m) _Pragma("unroll") for (int k = 0; k < 2; ++k) dst[m][k] = *(const PG8_LAS bf16x8*)(lds + PG8_SA(b, h) + aoff + m * 2048 + k * 1024); } while (0)
#define PG8_LDB(dst, b, h) do { _Pragma("unroll") for (int n = 0; n < 2; ++n) _Pragma("unroll") for (int k = 0; k < 2; ++k) dst[n][k] = *(const PG8_LAS bf16x8*)(lds + PG8_SB(b, h) + boff + n * 2048 + k * 1024); } while (0)
#define PG8_MMA(ai, bj, At, Bt) do { __builtin_amdgcn_s_setprio(1); _Pragma("unroll") for (int m = 0; m < 4; ++m) _Pragma("unroll") for (int n = 0; n < 2; ++n) _Pragma("unroll") for (int k = 0; k < 2; ++k) \
        acc[ai][bj][m][n] = __builtin_amdgcn_mfma_f32_16x16x32_bf16(Bt[n][k], At[m][k], acc[ai][bj][m][n], 0, 0, 0); __builtin_amdgcn_s_setprio(0); } while (0)
#define PG8_WAIT_V(n) asm volatile("s_waitcnt vmcnt(" #n ")" ::: "memory")
#define PG8_WAIT_L(n) asm volatile("s_waitcnt lgkmcnt(" #n ")" ::: "memory")
#define PG8_BAR __builtin_amdgcn_s_barrier()
#define PG8_SCHED __builtin_amdgcn_sched_barrier(0)
    Unit cur, nxt; int ui = 0;
    if (!S.next(0, cur)) return;
    f32x4 acc[2][2][4][2];
#pragma unroll
    for (int a = 0; a < 2; ++a)
#pragma unroll
        for (int b = 0; b < 2; ++b)
#pragma unroll
            for (int m = 0; m < 4; ++m)
#pragma unroll
                for (int n = 0; n < 2; ++n) acc[a][b][m][n] = (f32x4){0.f, 0.f, 0.f, 0.f};
    bf16x8 At[4][2], B0[2][2], B1[2][2];
    const char* cA = (const char*)g.A + (size_t)cur.pm * tstep + (size_t)cur.k0 * 2; const char* cB = (const char*)g.Bt + (size_t)cur.pn * tstep + (size_t)cur.k0 * 2;
    S.a_ready(cur);
    if constexpr (SP2) {
        PG8_STAGE(PG8_SB(0, 0), cB, voffB); PG8_STAGE(PG8_SB(0, 1), cB + hstep, voffB); PG8_STAGE(PG8_SA(0, 0), cA, voffA); PG8_STAGE(PG8_SA(0, 1), cA + hstep, voffA);
        if (wr == 1) PG8_BAR;
        PG8_WAIT_V(2); PG8_BAR;
        PG8_STAGE(PG8_SB(1, 0), cB + kstep, voffB); PG8_STAGE(PG8_SA(1, 0), cA + kstep, voffA); PG8_STAGE(PG8_SB(1, 1), cB + hstep + kstep, voffB);
        PG8_WAIT_V(6); PG8_BAR;
    } else {
        PG8_STAGE(PG8_SB(0, 0), cB, voffB); PG8_STAGE(PG8_SA(0, 0), cA, voffA); PG8_STAGE(PG8_SB(0, 1), cB + hstep, voffB); PG8_STAGE(PG8_SA(0, 1), cA + hstep, voffA);
        if (wr == 1) PG8_BAR;
        PG8_WAIT_V(4); PG8_BAR;
        PG8_STAGE(PG8_SB(1, 0), cB + kstep, voffB); PG8_STAGE(PG8_SA(1, 0), cA + kstep, voffA); PG8_STAGE(PG8_SB(1, 1), cB + hstep + kstep, voffB);
        PG8_WAIT_V(6); PG8_BAR;
    }
    for (;;) {
        const bool has_next = S.next(ui + 1, nxt);
        const char* nA = has_next ? (const char*)g.A + (size_t)nxt.pm * tstep + (size_t)nxt.k0 * 2 : cA; const char* nB = has_next ? (const char*)g.Bt + (size_t)nxt.pn * tstep + (size_t)nxt.k0 * 2 : cB;
        const int nt = cur.nt;
        for (int t = 0; t < nt; t += 2) {
            const bool last = (t == nt - 2);
            const char* a1 = cA + (size_t)(t + 1) * kstep;
            const char* a2 = last ? nA : cA + (size_t)(t + 2) * kstep; const char* b2 = last ? nB : cB + (size_t)(t + 2) * kstep;
            const char* a3 = a2 + kstep; const char* b3 = b2 + kstep;
            if (last && has_next) S.a_ready(nxt);
            if constexpr (SP2) {
            PG8_LDB(B0, 0, 0); PG8_LDB(B1, 0, 1); PG8_SCHED; PG8_LDA(At, 0, 0); PG8_STAGE(PG8_SA(1, 1), a1 + hstep, voffA);
            PG8_WAIT_V(8); PG8_WAIT_L(0); PG8_BAR; PG8_MMA(0, 0, At, B0); PG8_MMA(0, 1, At, B1); PG8_BAR; PG8_SCHED;
            PG8_LDA(At, 0, 1); PG8_STAGE(PG8_SB(0, 0), b2, voffB); PG8_STAGE(PG8_SB(0, 1), b2 + hstep, voffB); PG8_STAGE(PG8_SA(0, 0), a2, voffA);
            PG8_WAIT_V(8); PG8_WAIT_L(0); PG8_BAR; PG8_MMA(1, 0, At, B0); PG8_MMA(1, 1, At, B1); PG8_BAR; PG8_SCHED;
            PG8_LDB(B0, 1, 0); PG8_LDB(B1, 1, 1); PG8_SCHED; PG8_LDA(At, 1, 0); PG8_STAGE(PG8_SA(0, 1), a2 + hstep, voffA);
            PG8_WAIT_V(8); PG8_WAIT_L(0); PG8_BAR; PG8_MMA(0, 0, At, B0); PG8_MMA(0, 1, At, B1); PG8_BAR; PG8_SCHED;
            PG8_LDA(At, 1, 1); PG8_STAGE(PG8_SB(1, 0), b3, voffB); PG8_STAGE(PG8_SB(1, 1), b3 + hstep, voffB); PG8_STAGE(PG8_SA(1, 0), a3, voffA);
            PG8_WAIT_V(8); PG8_WAIT_L(0); PG8_BAR; PG8_MMA(1, 0, At, B0); PG8_MMA(1, 1, At, B1); PG8_BAR; PG8_SCHED;
            } else {
            PG8_LDB(B0, 0, 0); PG8_SCHED; PG8_LDA(At, 0, 0); PG8_STAGE(PG8_SA(1, 1), a1 + hstep, voffA);
            PG8_WAIT_L(8); PG8_BAR; PG8_WAIT_L(0); PG8_MMA(0, 0, At, B0); PG8_BAR; PG8_SCHED;
            PG8_LDB(B1, 0, 1); PG8_STAGE(PG8_SB(0, 0), b2, voffB);
            PG8_BAR; PG8_WAIT_L(0); PG8_MMA(0, 1, At, B1); PG8_BAR;
            PG8_LDA(At, 0, 1); PG8_STAGE(PG8_SA(0, 0), a2, voffA);
            PG8_BAR; PG8_WAIT_L(0); PG8_MMA(1, 0, At, B0); PG8_BAR; PG8_SCHED;
            PG8_STAGE(PG8_SB(0, 1), b2 + hstep, voffB);
            PG8_WAIT_V(6); PG8_BAR; PG8_MMA(1, 1, At, B1); PG8_BAR;
            PG8_LDB(B0, 1, 0); PG8_SCHED; PG8_LDA(At, 1, 0); PG8_STAGE(PG8_SA(0, 1), a2 + hstep, voffA);
            PG8_WAIT_L(8); PG8_BAR; PG8_WAIT_L(0); PG8_MMA(0, 0, At, B0); PG8_BAR; PG8_SCHED;
            PG8_LDB(B1, 1, 1); PG8_STAGE(PG8_SB(1, 0), b3, voffB);
            PG8_BAR; PG8_WAIT_L(0); PG8_MMA(0, 1, At, B1); PG8_BAR;
            PG8_LDA(At, 1, 1); PG8_STAGE(PG8_SA(1, 0), a3, voffA);
            PG8_BAR; PG8_WAIT_L(0); PG8_MMA(1, 0, At, B0); PG8_BAR; PG8_SCHED;
            PG8_STAGE(PG8_SB(1, 1), b3 + hstep, voffB);
            PG8_WAIT_V(6); PG8_BAR; PG8_MMA(1, 1, At, B1); PG8_BAR;
            }
        }
        if constexpr (ALIGN_EPI) { if (wr == 0) PG8_BAR; }
        if constexpr (!Epi::AFTER_DRAIN) { E(acc, cur, wr, wc, fr, fq); S.done(cur); }
        if (!has_next) break;
#pragma unroll
        for (int a = 0; a < 2; ++a)
#pragma unroll
            for (int b = 0; b < 2; ++b)
#pragma unroll
                for (int m = 0; m < 4; ++m)
#pragma unroll
                    for (int n = 0; n < 2; ++n) acc[a][b][m][n] = (f32x4){0.f, 0.f, 0.f, 0.f};
        cur = nxt; cA = nA; cB = nB; ++ui;
        if constexpr (ALIGN_EPI) { if (wr == 1) PG8_BAR; }
    }
    PG8_WAIT_V(0);
    if constexpr (!ALIGN_EPI) { if (wr == 0) PG8_BAR; }
    PG8_BAR;
    if constexpr (Epi::AFTER_DRAIN) { E.fused(acc, cur, wr, wc, fr, fq, lds, wid, lane); S.done(cur); }
#undef PG8_SA
#undef PG8_SB
#undef PG8_STAGE
#undef PG8_LDA
#undef PG8_LDB
#undef PG8_MMA
#undef PG8_WAIT_V
#undef PG8_WAIT_L
#undef PG8_BAR
#undef PG8_SCHED
}
}

#ifndef ONE_LAUNCH
#define ONE_LAUNCH 1
#endif
namespace cg = cooperative_groups;
namespace pg8 {
#define LAS __attribute__((address_space(3)))
typedef float f32x16 __attribute__((ext_vector_type(16)));
typedef unsigned u32x2 __attribute__((ext_vector_type(2)));
constexpr int DM = 2048, TP = 4096, MP = 8192, MR = 8320, MT = 8448;
constexpr int RPROJ = 3360, PTOT = 7472, NIN = 7680, DFF = 8192;
constexpr int C_Q = 3360, C_K = 4384, C_V = 5408, C_F = 6432, C_OG = 6448;
constexpr int KL = 384, NL = 3072;
constexpr float ALPHA_RES = 1.189207115002721f;
constexpr float LOG2E = 1.4426950408889634f;
constexpr float QSCALE = 0.125f * 1.4426950408889634f;
constexpr size_t OFF_YS = 16777216, OFF_PK = 17039360, OFF_PV = 25427968, OFF_PLOGF = 33816576, OFF_PWKV = 33947648, OFF_PSHIFT = 34078720,
                 OFF_SK = 34085440, OFF_SV = 34216512, OFF_SLOGF = 34347584, OFF_SWKV = 34349632, OFF_SSHIFT = 34873920, OUT_TOTAL = 34900800;
constexpr size_t MiB = 1u << 20;
constexpr size_t WS_CTL = 0, WS_WIN = 1 * MiB, WS_LIN = 1 * MiB, WS_G = 8 * MiB, WS_KE = 25 * MiB, WS_WO = 31 * MiB, WS_WUP = 39 * MiB, WS_WDN = 71 * MiB, WS_LORA = 103 * MiB,
                 WS_XB = 106 * MiB, WS_YMIX = 106 * MiB, WS_PR = 139 * MiB, WS_HB = 139 * MiB, WS_Q = 194 * MiB, WS_KB = 210 * MiB + MiB / 2, WS_VT = 227 * MiB, WS_OG = 243 * MiB + MiB / 2,
                 WS_SLAB1 = 1 * MiB, WS_SLAB2 = 8 * MiB, WS_W = 260 * MiB, WS_ALR = 293 * MiB, WS_U = 172 * MiB, WS_END = 310 * MiB;
constexpr int LDS_BYTES = 147456, LDS_WORD_OFF = 140032, LDS_BARW_OFF = 140096, CW_BAR = 4096;
constexpr int NPH = 11;

struct Args { const float* in[28]; float* out; unsigned char* ws; int ph_lo, ph_hi, rep, pad; };

__device__ __forceinline__ unsigned f2bf(float f) { unsigned u = __builtin_bit_cast(unsigned, f); return (u + 0x7fffu + ((u >> 16) & 1u)) >> 16; }
__device__ __forceinline__ float bf2f(unsigned h) { return __builtin_bit_cast(float, h << 16); }
__device__ __forceinline__ float bflo(unsigned p) { return __builtin_bit_cast(float, p << 16); }
__device__ __forceinline__ float bfhi(unsigned p) { return __builtin_bit_cast(float, p & 0xffff0000u); }
__device__ __forceinline__ unsigned pk2(float lo, float hi) { return f2bf(lo) | (f2bf(hi) << 16); }
__device__ __forceinline__ float sigmoidf_(float x) { return 1.0f / (1.0f + __expf(-x)); }
#define LDS_WAIT() asm volatile("s_waitcnt lgkmcnt(0)" ::: "memory")

struct EpiIn {
    static constexpr bool PERM = true, AFTER_DRAIN = false;
    bf16_t *PR, *Q, *KB, *VT, *OG; float* out; const float* b_f;
    __device__ __forceinline__ void one(const f32x4 v0, const f32x4 v1, const int row, const int c0) const {
        if (c0 < C_Q) {
            u32x4 w; w.x = cvt_pk_bf16(v0[0], v0[1]); w.y = cvt_pk_bf16(v0[2], v0[3]); w.z = cvt_pk_bf16(v1[0], v1[1]); w.w = cvt_pk_bf16(v1[2], v1[3]);
            *(u32x4*)(PR + (size_t)row * RPROJ + c0) = w;
            if (row < MP) { if ((row & (TP - 1)) == TP - 1) { float* o = out + OFF_PSHIFT + (size_t)(row >> 12) * RPROJ + c0; *(f32x4*)o = v0; *(f32x4*)(o + 4) = v1; } }
            else { const int sr = row - MP; if ((sr & 15) == 15) { float* o = out + OFF_SSHIFT + (size_t)(sr >> 4) * RPROJ + c0; *(f32x4*)o = v0; *(f32x4*)(o + 4) = v1; } }
        } else if (c0 < C_K) {
            const f32x4 a = v0 * QSCALE, b = v1 * QSCALE;
            u32x4 w; w.x = cvt_pk_bf16(a[0], a[1]); w.y = cvt_pk_bf16(a[2], a[3]); w.z = cvt_pk_bf16(b[0], b[1]); w.w = cvt_pk_bf16(b[2], b[3]);
            *(u32x4*)(Q + (size_t)row * 1024 + (c0 - C_Q)) = w;
        } else if (c0 < C_V) {
            const int col = c0 - C_K;
            float* o = (row < MP) ? out + OFF_PK + (size_t)row * 1024 + col : out + OFF_SK + (size_t)(row - MP) * 1024 + col;
            *(f32x4*)o = v0; *(f32x4*)(o + 4) = v1;
            if (row < MP) { u32x4 w; w.x = cvt_pk_bf16(v0[0], v0[1]); w.y = cvt_pk_bf16(v0[2], v0[3]); w.z = cvt_pk_bf16(v1[0], v1[1]); w.w = cvt_pk_bf16(v1[2], v1[3]);
                *(u32x4*)(KB + (size_t)row * 1024 + col) = w; }
        } else if (c0 < C_F) {
            const int col = c0 - C_V;
            float* o = (row < MP) ? out + OFF_PV + (size_t)row * 1024 + col : out + OFF_SV + (size_t)(row - MP) * 1024 + col;
            *(f32x4*)o = v0; *(f32x4*)(o + 4) = v1;
            if (row < MP) {
                const int bb = row >> 12, t = row & (TP - 1), hh = col >> 6, d0 = col & 63;
                bf16_t* vt = VT + ((size_t)(bb * 16 + hh) * 64 + d0) * TP + t;
                const unsigned p0 = cvt_pk_bf16(v0[0], v0[1]), p1 = cvt_pk_bf16(v0[2], v0[3]), p2 = cvt_pk_bf16(v1[0], v1[1]), p3 = cvt_pk_bf16(v1[2], v1[3]);
                vt[0] = (bf16_t)(p0 & 0xffffu); vt[(size_t)1 * TP] = (bf16_t)(p0 >> 16); vt[(size_t)2 * TP] = (bf16_t)(p1 & 0xffffu); vt[(size_t)3 * TP] = (bf16_t)(p1 >> 16);
                vt[(size_t)4 * TP] = (bf16_t)(p2 & 0xffffu); vt[(size_t)5 * TP] = (bf16_t)(p2 >> 16); vt[(size_t)6 * TP] = (bf16_t)(p3 & 0xffffu); vt[(size_t)7 * TP] = (bf16_t)(p3 >> 16);
            }
        } else if (c0 < C_OG) {
            const int h0 = c0 - C_F;
            float* o = (row < MP) ? out + OFF_PLOGF + (size_t)row * 16 + h0 : out + OFF_SLOGF + (size_t)(row - MP) * 16 + h0;
            f32x4 r0, r1;
#pragma unroll
            for (int j = 0; j < 4; ++j) {
                const float x0 = v0[j] + b_f[h0 + j], x1 = v1[j] + b_f[h0 + 4 + j];
                r0[j] = fminf(x0, 0.f) - __logf(1.0f + __expf(-fabsf(x0))); r1[j] = fminf(x1, 0.f) - __logf(1.0f + __expf(-fabsf(x1)));
            }
            *(f32x4*)o = r0; *(f32x4*)(o + 4) = r1;
        } else if (c0 < PTOT) {
            f32x4 a, b;
#pragma unroll
            for (int j = 0; j < 4; ++j) { a[j] = sigmoidf_(v0[j]); b[j] = sigmoidf_(v1[j]); }
            u32x4 w; w.x = cvt_pk_bf16(a[0], a[1]); w.y = cvt_pk_bf16(a[2], a[3]); w.z = cvt_pk_bf16(b[0], b[1]); w.w = cvt_pk_bf16(b[2], b[3]);
            *(u32x4*)(OG + (size_t)row * 1024 + (c0 - C_OG)) = w;
        }
    }
    template <int I> __device__ __forceinline__ void rows(const f32x4 (&acc)[2][2][4][2], const int row0, const int cb) const {
        constexpr int ai = I >> 2, m = I & 3;
        const int row = row0 + ai * HALF + m * 16;
        if (row < MR) { one(acc[ai][0][m][0], acc[ai][0][m][1], row, cb); one(acc[ai][1][m][0], acc[ai][1][m][1], row, cb + HALF); }
    }
    __device__ __forceinline__ void operator()(const f32x4 (&acc)[2][2][4][2], const Unit& u, int wr, int wc, int fr, int fq) const {
        const int row0 = u.pm * BM + wr * 64 + fr;
        const int cb = u.pn * BM + wc * 32 + 8 * fq;
        rows<0>(acc, row0, cb); rows<1>(acc, row0, cb); rows<2>(acc, row0, cb); rows<3>(acc, row0, cb);
        rows<4>(acc, row0, cb); rows<5>(acc, row0, cb); rows<6>(acc, row0, cb); rows<7>(acc, row0, cb);
    }
};

struct EpiLora {
    static constexpr bool PERM = true, AFTER_DRAIN = false;
    float* W; bf16_t *ALR, *G; const float *w0, *a0;
    template <int REG> __device__ __forceinline__ void one(const f32x4 x0, const f32x4 x1, const int row, const int c0) const {
        if (REG == 0) {
            const f32x4 v0 = x0 + *(const f32x4*)(w0 + c0), v1 = x1 + *(const f32x4*)(w0 + c0 + 4);
            f32x4 r0, r1;
#pragma unroll
            for (int j = 0; j < 4; ++j) {
                const float p0 = v0[j], p1 = v1[j];
                const float l0 = fminf(p0, 0.f) - __logf(1.0f + __expf(-fabsf(p0))) - 0.5f, l1 = fminf(p1, 0.f) - __logf(1.0f + __expf(-fabsf(p1))) - 0.5f;
                r0[j] = __expf(-__expf(l0)); r1[j] = __expf(-__expf(l1));
            }
            float* o = W + (size_t)row * 1024 + c0; *(f32x4*)o = r0; *(f32x4*)(o + 4) = r1;
        } else if (REG == 1) {
            const f32x4 v0 = x0 + *(const f32x4*)(a0 + c0 - 1024), v1 = x1 + *(const f32x4*)(a0 + c0 - 1020);
            f32x4 a, b;
#pragma unroll
            for (int j = 0; j < 4; ++j) { a[j] = sigmoidf_(v0[j]); b[j] = sigmoidf_(v1[j]); }
            u32x4 w; w.x = cvt_pk_bf16(a[0], a[1]); w.y = cvt_pk_bf16(a[2], a[3]); w.z = cvt_pk_bf16(b[0], b[1]); w.w = cvt_pk_bf16(b[2], b[3]);
            *(u32x4*)(ALR + (size_t)row * 1024 + (c0 - 1024)) = w;
        } else {
            u32x4 w; w.x = cvt_pk_bf16(x0[0], x0[1]); w.y = cvt_pk_bf16(x0[2], x0[3]); w.z = cvt_pk_bf16(x1[0], x1[1]); w.w = cvt_pk_bf16(x1[2], x1[3]);
            *(u32x4*)(G + (size_t)row * 1024 + (c0 - 2048)) = w;
        }
    }
    template <int I, int REG> __device__ __forceinline__ void rows(const f32x4 (&acc)[2][2][4][2], const int row0, const int cb) const {
        constexpr int ai = I >> 2, m = I & 3;
        const int row = row0 + ai * HALF + m * 16;
        if (row < MR) { one<REG>(acc[ai][0][m][0], acc[ai][0][m][1], row, cb); one<REG>(acc[ai][1][m][0], acc[ai][1][m][1], row, cb + HALF); }
    }
    template <int REG> __device__ __forceinline__ void all(const f32x4 (&acc)[2][2][4][2], const int row0, const int cb) const {
        rows<0, REG>(acc, row0, cb); rows<1, REG>(acc, row0, cb); rows<2, REG>(acc, row0, cb); rows<3, REG>(acc, row0, cb);
        rows<4, REG>(acc, row0, cb); rows<5, REG>(acc, row0, cb); rows<6, REG>(acc, row0, cb); rows<7, REG>(acc, row0, cb);
    }
    __device__ __forceinline__ void operator()(const f32x4 (&acc)[2][2][4][2], const Unit& u, int wr, int wc, int fr, int fq) const {
        const int row0 = u.pm * BM + wr * 64 + fr;
        const int cb = u.pn * BM + wc * 32 + 8 * fq;
        const int reg = __builtin_amdgcn_readfirstlane(u.pn >> 2);
        if (reg == 0) all<0>(acc, row0, cb); else if (reg == 1) all<1>(acc, row0, cb); else all<2>(acc, row0, cb);
    }
};

struct EpiRes {
    static constexpr bool PERM = true, AFTER_DRAIN = false;
    const float* basep; const bf16_t* baseh; float* Z; float* slab; int KC;
    __device__ __forceinline__ void operator()(const f32x4 (&acc)[2][2][4][2], const Unit& u, int wr, int wc, int fr, int fq) const {
        if (u.smp) {
            float* sp = slab + (size_t)(u.k0 / KC) * (128 * DM) + (size_t)(wr * 64 + fr) * DM + u.pn * BM + wc * 32 + 8 * fq;
#pragma unroll
            for (int m = 0; m < 4; ++m)
#pragma unroll
                for (int bj = 0; bj < 2; ++bj) { *(f32x4*)(sp + (size_t)m * 16 * DM + bj * HALF) = acc[0][bj][m][0]; *(f32x4*)(sp + (size_t)m * 16 * DM + bj * HALF + 4) = acc[0][bj][m][1]; }
            return;
        }
        const int row0 = u.pm * BM + wr * 64 + fr;
#pragma unroll
        for (int ai = 0; ai < 2; ++ai)
#pragma unroll
            for (int m = 0; m < 4; ++m) {
                const int row = row0 + ai * HALF + m * 16;
                const float* bp = basep + (size_t)row * DM;
                float* zp = Z + (size_t)row * DM;
#pragma unroll
                for (int bj = 0; bj < 2; ++bj) {
                    const int c0 = u.pn * BM + bj * HALF + wc * 32 + 8 * fq;
                    f32x4 x0, x1;
                    if (basep) { x0 = *(const f32x4*)(bp + c0); x1 = *(const f32x4*)(bp + c0 + 4); }
                    else { const u32x4 hb = *(const u32x4*)(baseh + (size_t)row * DM + c0); x0 = (f32x4){bflo(hb.x), bfhi(hb.x), bflo(hb.y), bfhi(hb.y)}; x1 = (f32x4){bflo(hb.z), bfhi(hb.z), bflo(hb.w), bfhi(hb.w)}; }
                    *(f32x4*)(zp + c0) = x0 * ALPHA_RES + acc[ai][bj][m][0]; *(f32x4*)(zp + c0 + 4) = x1 * ALPHA_RES + acc[ai][bj][m][1];
                }
            }
    }
};

struct EpiUp {
    static constexpr bool PERM = true, AFTER_DRAIN = false;
    bf16_t* U;
    __device__ __forceinline__ void operator()(const f32x4 (&acc)[2][2][4][2], const Unit& u, int wr, int wc, int fr, int fq) const {
        const int row0 = u.pm * BM + wr * 64 + fr;
#pragma unroll
        for (int ai = 0; ai < 2; ++ai)
#pragma unroll
            for (int m = 0; m < 4; ++m) {
                bf16_t* rowp = U + (size_t)(row0 + ai * HALF + m * 16) * DFF + u.pn * BM + wc * 32 + 8 * fq;
#pragma unroll
                for (int bj = 0; bj < 2; ++bj) {
                    f32x4 v0 = acc[ai][bj][m][0], v1 = acc[ai][bj][m][1];
#pragma unroll
                    for (int j = 0; j < 4; ++j) { const float a = fmaxf(v0[j], 0.f), b = fmaxf(v1[j], 0.f); v0[j] = a * a; v1[j] = b * b; }
                    u32x4 w; w.x = cvt_pk_bf16(v0[0], v0[1]); w.y = cvt_pk_bf16(v0[2], v0[3]); w.z = cvt_pk_bf16(v1[0], v1[1]); w.w = cvt_pk_bf16(v1[2], v1[3]);
                    *(u32x4*)(rowp + bj * HALF) = w;
                }
            }
    }
};

__device__ __forceinline__ float wave_sum(float v) {
#pragma unroll
    for (int o = 1; o < 64; o <<= 1) v += __shfl_xor(v, o);
    return v;
}
__device__ __forceinline__ float wave_max(float v) {
#pragma unroll
    for (int o = 1; o < 64; o <<= 1) v = fmaxf(v, __shfl_xor(v, o));
    return v;
}
__device__ __forceinline__ float red32(float v) {
#pragma unroll
    for (int o = 1; o < 32; o <<= 1) v += __shfl_xor(v, o);
    return v;
}
template <int CTRL> __device__ __forceinline__ float dpp_add(float x) {
    return x + __builtin_bit_cast(float, __builtin_amdgcn_update_dpp(0, __builtin_bit_cast(int, x), CTRL, 0xf, 0xf, false));
}
__device__ __forceinline__ float row16_sum(float x) {
    x = dpp_add<0xB1>(x); x = dpp_add<0x4E>(x); x = dpp_add<0x141>(x); x = dpp_add<0x140>(x); return x;
}

__device__ __forceinline__ void p0_transpose_item(const float* __restrict__ W, int K, int N, bf16_t* __restrict__ WT, LAS float* scr, int item, int lane) {
    const int nblk = (N + 31) >> 5, kb = item / nblk, nb = item - kb * nblk, k0 = 64 * kb, n0 = 32 * nb;
    const int kr = lane >> 3, n4 = (lane & 7) * 4; const bool ok = (n0 + n4) < N;
    f32x4 v[8];
#pragma unroll
    for (int i = 0; i < 8; ++i) v[i] = ok ? *(const f32x4*)(W + (size_t)(k0 + kr + 8 * i) * N + n0 + n4) : (f32x4){0.f, 0.f, 0.f, 0.f};
#pragma unroll
    for (int i = 0; i < 8; ++i) { LAS float* d = scr + (kr + 8 * i) * 33 + n4; d[0] = v[i][0]; d[1] = v[i][1]; d[2] = v[i][2]; d[3] = v[i][3]; }
    LDS_WAIT();
    const int c = lane & 7;
#pragma unroll
    for (int j = 0; j < 4; ++j) { const int n = (lane >> 3) + 8 * j; const LAS float* s = scr + (8 * c) * 33 + n;
        u32x4 o; o.x = pk2(s[0 * 33], s[1 * 33]); o.y = pk2(s[2 * 33], s[3 * 33]); o.z = pk2(s[4 * 33], s[5 * 33]); o.w = pk2(s[6 * 33], s[7 * 33]);
        *(u32x4*)(WT + (size_t)(n0 + n) * K + k0 + 8 * c) = o; }
    LDS_WAIT();
}
constexpr int I_IN = (DM / 64) * ((PTOT + 31) / 32), I_O = (DM / 64) * (DM / 32), I_UP = (DM / 64) * (DFF / 32), I_DN = (DFF / 64) * (DM / 32);
__device__ __forceinline__ void late_transpose_item(const Args& a, LAS float* scr, int r, int lane) {
    unsigned char* ws = a.ws;
    if (r < I_O) { p0_transpose_item(a.in[21], DM, DM, (bf16_t*)(ws + WS_WO), scr, r, lane); return; } r -= I_O;
    if (r < I_UP) { p0_transpose_item(a.in[24], DM, DFF, (bf16_t*)(ws + WS_WUP), scr, r, lane); return; } r -= I_UP;
    if (r < I_DN) p0_transpose_item(a.in[25], DFF, DM, (bf16_t*)(ws + WS_WDN), scr, r, lane);
}

__device__ __forceinline__ void late_item_desc(const Args& a, int r, const float*& W, bf16_t*& WT, int& K, int& N, int& ri) {
    unsigned char* ws = a.ws;
    if (r < I_O) { W = a.in[21]; WT = (bf16_t*)(ws + WS_WO); K = DM; N = DM; ri = r; }
    else if (r < I_O + I_UP) { W = a.in[24]; WT = (bf16_t*)(ws + WS_WUP); K = DM; N = DFF; ri = r - I_O; }
    else { W = a.in[25]; WT = (bf16_t*)(ws + WS_WDN); K = DFF; N = DM; ri = r - I_O - I_UP; }
}
__device__ __forceinline__ void late_item_load(const Args& a, int r, int lane, f32x4 (&v)[8]) {
    const float* W; bf16_t* WT; int K, N, ri; late_item_desc(a, r, W, WT, K, N, ri);
    const int nblk = N >> 5, kb = ri / nblk, nb = ri - kb * nblk, k0 = 64 * kb, n0 = 32 * nb, kr = lane >> 3, n4 = (lane & 7) * 4;
#pragma unroll
    for (int i = 0; i < 8; ++i) v[i] = *(const f32x4*)(W + (size_t)(k0 + kr + 8 * i) * N + n0 + n4);
}
__device__ __forceinline__ void late_item_finish(const Args& a, int r, int lane, const f32x4 (&v)[8], LAS float* scr) {
    const float* W; bf16_t* WT; int K, N, ri; late_item_desc(a, r, W, WT, K, N, ri);
    const int nblk = N >> 5, kb = ri / nblk, nb = ri - kb * nblk, k0 = 64 * kb, n0 = 32 * nb, kr = lane >> 3, n4 = (lane & 7) * 4;
#pragma unroll
    for (int i = 0; i < 8; ++i) { LAS float* d = scr + (kr + 8 * i) * 33 + n4; d[0] = v[i][0]; d[1] = v[i][1]; d[2] = v[i][2]; d[3] = v[i][3]; }
    LDS_WAIT();
    const int c = lane & 7;
#pragma unroll
    for (int j = 0; j < 4; ++j) { const int n = (lane >> 3) + 8 * j; const LAS float* s = scr + (8 * c) * 33 + n;
        u32x4 o; o.x = pk2(s[0 * 33], s[1 * 33]); o.y = pk2(s[2 * 33], s[3 * 33]); o.z = pk2(s[4 * 33], s[5 * 33]); o.w = pk2(s[6 * 33], s[7 * 33]);
        *(u32x4*)(WT + (size_t)(n0 + n) * K + k0 + 8 * c) = o; }
    LDS_WAIT();
}

__device__ __forceinline__ void phase0(const Args& a, LAS unsigned char* lds) {
    const int tid = threadIdx.x, lane = tid & 63, wave = tid >> 6, G = gridDim.x;
    unsigned char* ws = a.ws;
    if (blockIdx.x == 0 && tid < 256) ((unsigned*)(ws + WS_CTL))[tid] = 0u;
    LAS float* scr = (LAS float*)(lds + wave * 16384);
    const int gw = blockIdx.x * 8 + wave, NGW = G * 8;
    for (int it = gw; it < I_IN; it += NGW) p0_transpose_item(a.in[7], DM, PTOT, (bf16_t*)(ws + WS_WIN), scr, it, lane);
    const int gt = blockIdx.x * 512 + tid, NT = G * 512;
    { bf16_t* XB = (bf16_t*)(ws + WS_XB);
      for (int i = gt; i < MT * 256; i += NT) { const int row = i >> 8, c8 = (i & 255) * 8;
          u32x4 o = (u32x4){0u, 0u, 0u, 0u};
          if (row < MR) { const float* src = (row < MP) ? a.in[0] + (size_t)row * DM + c8 : a.in[1] + (size_t)(row - MP) * DM + c8;
              const f32x4 x0 = *(const f32x4*)src, x1 = *(const f32x4*)(src + 4);
              o.x = pk2(x0[0], x0[1]); o.y = pk2(x0[2], x0[3]); o.z = pk2(x1[0], x1[1]); o.w = pk2(x1[2], x1[3]); }
          *(u32x4*)(XB + (size_t)row * DM + c8) = o; } }
    { bf16_t* LT = (bf16_t*)(ws + WS_LORA);
      const float* w2 = a.in[10]; const float* a2 = a.in[12]; const float* g2 = a.in[13];
      for (int i = gt; i < NL * KL; i += NT) { const int n = i / KL, c = i - n * KL; float v = 0.f;
          if (n < 1024) { if (c < 64) v = w2[c * 1024 + n]; }
          else if (n < 2048) { if (c >= 64 && c < 128) v = a2[(c - 64) * 1024 + (n - 1024)]; }
          else { if (c >= 128 && c < 288) v = g2[(c - 128) * 1024 + (n - 2048)]; }
          LT[i] = (bf16_t)f2bf(v); } }
}

__device__ __forceinline__ void phase2(const Args& a) {
    const int tid = threadIdx.x, lane = tid & 63, wave = tid >> 6, G = gridDim.x;
    unsigned char* ws = a.ws;
    const bf16_t* PR = (const bf16_t*)(ws + WS_PR); bf16_t* LIN = (bf16_t*)(ws + WS_LIN);
    const float* mu = a.in[8]; const float* sshift = a.in[6];
    const int gt = blockIdx.x * 512 + tid, NT = G * 512;
    for (int i = gt; i < MT * (KL / 2); i += NT) {
        const int row = i / (KL / 2), j = (i - row * (KL / 2)) * 2;
        unsigned o = 0u;
        if (row < MR && j < 288) {
            const int col = 3072 + j;
            const unsigned pc = *(const unsigned*)(PR + (size_t)row * RPROJ + col);
            const float p0 = bflo(pc), p1 = bfhi(pc);
            float q0 = 0.f, q1 = 0.f;
            const int t = (row < MP) ? (row & (TP - 1)) : ((row - MP) & 15);
            if (t > 0) { const unsigned pp = *(const unsigned*)(PR + (size_t)(row - 1) * RPROJ + col); q0 = bflo(pp); q1 = bfhi(pp); }
            else if (row >= MP) { const float* s = sshift + (size_t)((row - MP) >> 4) * RPROJ + col; q0 = s[0]; q1 = s[1]; }
            const float x0 = p0 + (q0 - p0) * mu[col], x1 = p1 + (q1 - p1) * mu[col + 1];
            float f0, f1;
            if (j < 64) { f0 = tanhf(x0); f1 = tanhf(x1); } else if (j < 128) { f0 = x0; f1 = x1; } else { f0 = sigmoidf_(x0); f1 = sigmoidf_(x1); }
            o = pk2(f0, f1);
        }
        *(unsigned*)(LIN + (size_t)row * KL + j) = o;
    }
}
__device__ __forceinline__ void phase2_cumsum(const Args& a, unsigned char* lds, int b) {
    const int tid = threadIdx.x, lane = tid & 63, w = __builtin_amdgcn_readfirstlane(tid >> 6), h = lane & 15, tq = lane >> 4;
    float* wtot = (float*)lds;
    const float* lf = a.out + OFF_PLOGF + ((size_t)b * TP + 512 * w + tq) * 16 + h;
    float loc = 0.f;
#pragma unroll 16
    for (int i = 0; i < 128; ++i) loc += lf[64 * i];
    loc += __shfl_xor(loc, 16); loc += __shfl_xor(loc, 32);
    if (tq == 0) wtot[w * 16 + h] = loc;
    __syncthreads();
    float run = 0.f;
    for (int j = 0; j < w; ++j) run += wtot[j * 16 + h];
    bf16_t* KE = (bf16_t*)(a.ws + WS_KE) + ((size_t)(b * 16 + h) * TP + 512 * w + tq) * 4;
#pragma unroll 8
    for (int i = 0; i < 128; ++i) {
        float s1 = lf[64 * i];
        { const float n1 = __shfl_up(s1, 16); if (tq >= 1) s1 += n1; }
        { const float n2 = __shfl_up(s1, 32); if (tq >= 2) s1 += n2; }
        const float kb = -(run + s1) * LOG2E;
        run += __shfl(s1, 48 + h);
        const unsigned hi = f2bf(kb); const float r1 = kb - bf2f(hi);
        const unsigned mid = f2bf(r1); const float r2 = r1 - bf2f(mid);
        const unsigned lo = f2bf(r2);
        u32x2 o; o.x = hi | (mid << 16); o.y = lo;
        *(u32x2*)(KE + 16 * i) = o;
    }
    __syncthreads();
}

__device__ __forceinline__ void ln_phase(float* Z, const float* g, const float* bta, bf16_t* HB, const float* sbase, const float* slab, const int nslab) {
    const int tid = threadIdx.x, lane = tid & 63, wave = tid >> 6;
    const int gw = blockIdx.x * 8 + wave, NGW = gridDim.x * 8;
    for (int it = gw; it < MT; it += NGW) {
        const int row = (it < 128) ? MP + it : (it < MR ? it - 128 : it);
        if (row >= MR) { if (HB) { u32x4* o = (u32x4*)(HB + (size_t)row * DM); for (int j = 0; j < 4; ++j) o[64 * j + lane] = (u32x4){0u, 0u, 0u, 0u}; } continue; }
        f32x4* zr = (f32x4*)(Z + (size_t)row * DM);
        f32x4 v[8]; float s = 0.f;
        if (row < MP) {
#pragma unroll
            for (int j = 0; j < 8; ++j) v[j] = zr[64 * j + lane];
        } else {
            const f32x4* br = (const f32x4*)(sbase + (size_t)(row - MP) * DM);
#pragma unroll
            for (int j = 0; j < 8; ++j) v[j] = br[64 * j + lane] * ALPHA_RES;
            for (int k = 0; k < nslab; ++k) { const f32x4* sr = (const f32x4*)(slab + ((size_t)k * 128 + (row - MP)) * DM);
#pragma unroll
                for (int j = 0; j < 8; ++j) v[j] += sr[64 * j + lane]; }
        }
#pragma unroll
        for (int j = 0; j < 8; ++j) s += (v[j][0] + v[j][1]) + (v[j][2] + v[j][3]);
        const float mean = wave_sum(s) * (1.f / DM); float s2 = 0.f;
#pragma unroll
        for (int j = 0; j < 8; ++j) { v[j] = v[j] - mean; s2 += (v[j][0] * v[j][0] + v[j][1] * v[j][1]) + (v[j][2] * v[j][2] + v[j][3] * v[j][3]); }
        const float rstd = rsqrtf(wave_sum(s2) * (1.f / DM) + 1e-5f);
#pragma unroll
        for (int j = 0; j < 8; ++j) {
            const f32x4 gg = ((const f32x4*)g)[64 * j + lane], bb = ((const f32x4*)bta)[64 * j + lane];
            const f32x4 y = v[j] * rstd * gg + bb;
            if (!HB || row >= MP) zr[64 * j + lane] = y;
            if (HB) { u32x2 o; o.x = pk2(y[0], y[1]); o.y = pk2(y[2], y[3]); *(u32x2*)(HB + (size_t)row * DM + (64 * j + lane) * 4) = o; }
        }
    }
}

__device__ __forceinline__ float row32_sum(float x) {
    x = row16_sum(x);
    float xa = x, xb = x;
    asm volatile("s_nop 1\n\tv_permlane32_swap_b32 %0, %1" : "+v"(xa), "+v"(xb));
    return xa + xb;
}
__device__ __forceinline__ float half32_sum(float x) {
    x = row16_sum(x);
    return x + __shfl_xor(x, 16);
}
template <bool SAMPLE>
__device__ __forceinline__ void scan_unit(const Args& a, unsigned char* lds, int b, int h, int qt, int sbi) {
    constexpr int TC = SAMPLE ? 16 : 32, NCH = SAMPLE ? 1 : (TP / 32), NS = TC / 8;
    const int tid = threadIdx.x, lane = tid & 63, w = __builtin_amdgcn_readfirstlane(tid >> 6);
    const size_t rowbase = SAMPLE ? (size_t)(MP + b * 16) : (size_t)b * TP;
    unsigned char* ws = a.ws;
    float* buf = (float*)lds;
    if (w < 4) {
        const int s = lane & 15, row = qt * 16 + w * 4 + (lane >> 4);
        bf16_t* YM = (bf16_t*)(ws + WS_YMIX) + rowbase * DM + h * 64 + row;
        typedef float f32x2 __attribute__((ext_vector_type(2)));
        f32x2 S01 = (f32x2){0.f, 0.f}, S23 = (f32x2){0.f, 0.f};
        if (SAMPLE) { const f32x4 x = *(const f32x4*)(a.in[5] + ((size_t)(b * 16 + h) * 64 + row) * 64 + 4 * s); S01 = x.lo; S23 = x.hi; }
        __syncthreads();
        for (int n = 0; n < NCH; ++n) {
            const float* bb = buf + (n & 1) * (TC * 384);
#pragma unroll 1
            for (int hf = 0; hf < TC / 16; ++hf) {
                float yk = 0.f;
#pragma unroll 8
                for (int st = 0; st < 16; ++st) {
                    const float* p = bb + (hf * 16 + st) * 384;
                    const f32x4 w4 = *(const f32x4*)(p + 4 * s), kh4 = *(const f32x4*)(p + 64 + 4 * s), a4 = *(const f32x4*)(p + 128 + 4 * s), b4 = *(const f32x4*)(p + 192 + 4 * s), r4 = *(const f32x4*)(p + 256 + 4 * s);
                    const float v = p[320 + row];
                    const f32x2 vv = (f32x2){v, v};
                    const f32x2 pv = S01 * a4.lo + S23 * a4.hi;
                    const f32x2 u01 = S01 * w4.lo + vv * kh4.lo, u23 = S23 * w4.hi + vv * kh4.hi;
                    const float sa = row16_sum(pv.x + pv.y);
                    const f32x2 sv = (f32x2){sa, sa};
                    S01 = sv * b4.lo + u01; S23 = sv * b4.hi + u23;
                    const f32x2 qv = S01 * r4.lo + S23 * r4.hi;
                    const float y = row16_sum(qv.x + qv.y);
                    yk = (s == st) ? y : yk;
                }
                YM[((size_t)n * TC + hf * 16 + s) * DM] = (bf16_t)f2bf(yk);
            }
            __syncthreads();
        }
        *(f32x4*)(a.out + (SAMPLE ? OFF_SWKV : OFF_PWKV) + ((size_t)(b * 16 + h) * 64 + row) * 64 + 4 * s) = (f32x4){S01.x, S01.y, S23.x, S23.y};
    } else {
        const bf16_t* PR = (const bf16_t*)(ws + WS_PR); const float* Wd = (const float*)(ws + WS_W); const bf16_t* ALR = (const bf16_t*)(ws + WS_ALR);
        const int ptid = tid - 256, pst = ptid >> 5, cp = ptid & 31, ch = h * 64 + 2 * cp;
        const float mur0 = a.in[8][ch], mur1 = a.in[8][ch + 1], muk0 = a.in[8][1024 + ch], muk1 = a.in[8][1025 + ch], muv0 = a.in[8][2048 + ch], muv1 = a.in[8][2049 + ch];
        const float kk0 = a.in[14][ch], kk1 = a.in[14][ch + 1], ka0 = a.in[15][ch], ka1 = a.in[15][ch + 1], rk0 = a.in[16][ch], rk1 = a.in[16][ch + 1];
        bf16_t* BV = (bf16_t*)a.out;
        unsigned rc[NS], kc[NS], vc[NS], rp[NS], kp[NS], vp[NS], al[NS]; float w0[NS], w1[NS];
#define SCAN_LOAD(n) do { _Pragma("unroll") for (int i_ = 0; i_ < NS; ++i_) { const int st_ = pst + 8 * i_; const size_t row_ = rowbase + (size_t)(n) * TC + st_; const bf16_t* pr_ = PR + row_ * RPROJ + ch; \
        rc[i_] = *(const unsigned*)pr_; kc[i_] = *(const unsigned*)(pr_ + 1024); vc[i_] = *(const unsigned*)(pr_ + 2048); \
        if ((n) > 0 || st_ > 0) { rp[i_] = *(const unsigned*)(pr_ - RPROJ); kp[i_] = *(const unsigned*)(pr_ - RPROJ + 1024); vp[i_] = *(const unsigned*)(pr_ - RPROJ + 2048); } else { rp[i_] = 0u; kp[i_] = 0u; vp[i_] = 0u; } \
        { const float* wp_ = Wd + row_ * 1024 + ch; w0[i_] = wp_[0]; w1[i_] = wp_[1]; } al[i_] = *(const unsigned*)(ALR + row_ * 1024 + ch); } } while (0)
#define SCAN_PREP(n) do { _Pragma("unroll") for (int i_ = 0; i_ < NS; ++i_) { const int st_ = pst + 8 * i_; float* bb_ = buf + ((n) & 1) * (TC * 384) + st_ * 384; \
        const float r0_ = bflo(rc[i_]), r1_ = bfhi(rc[i_]), k0_ = bflo(kc[i_]), k1_ = bfhi(kc[i_]), v0_ = bflo(vc[i_]), v1_ = bfhi(vc[i_]); \
        float rq0 = bflo(rp[i_]), rq1 = bfhi(rp[i_]), kq0 = bflo(kp[i_]), kq1 = bfhi(kp[i_]), vq0 = bflo(vp[i_]), vq1 = bfhi(vp[i_]); \
        if (SAMPLE && (n) == 0 && st_ == 0) { const float* sh_ = a.in[6] + (size_t)b * RPROJ + ch; rq0 = sh_[0]; rq1 = sh_[1]; kq0 = sh_[1024]; kq1 = sh_[1025]; vq0 = sh_[2048]; vq1 = sh_[2049]; } \
        const float rs0 = r0_ + (rq0 - r0_) * mur0, rs1 = r1_ + (rq1 - r1_) * mur1, ks0 = k0_ + (kq0 - k0_) * muk0, ks1 = k1_ + (kq1 - k1_) * muk1; \
        const float vs0 = v0_ + (vq0 - v0_) * muv0, vs1 = v1_ + (vq1 - v1_) * muv1; \
        const float n0_ = ks0 * kk0, n1_ = ks1 * kk1; const float ss_ = half32_sum(n0_ * n0_ + n1_ * n1_); const float inv_ = 1.0f / fmaxf(sqrtf(ss_), 1e-12f); \
        const float kn0 = n0_ * inv_, kn1 = n1_ * inv_, al0 = bflo(al[i_]), al1 = bfhi(al[i_]); \
        const float kh0 = ks0 * (1.0f + (al0 - 1.0f) * ka0), kh1 = ks1 * (1.0f + (al1 - 1.0f) * ka1); \
        { const float bo_ = half32_sum(rs0 * kh0 * rk0 + rs1 * kh1 * rk1); if ((cp >> 3) == qt) *(unsigned*)(BV + (rowbase + (size_t)(n) * TC + st_) * 1024 + ch) = pk2(bo_ * vs0, bo_ * vs1); } \
        *(float2*)(bb_ + 2 * cp) = make_float2(w0[i_], w1[i_]); *(float2*)(bb_ + 64 + 2 * cp) = make_float2(kh0, kh1); *(float2*)(bb_ + 128 + 2 * cp) = make_float2(-kn0, -kn1); \
        *(float2*)(bb_ + 192 + 2 * cp) = make_float2(kn0 * al0, kn1 * al1); *(float2*)(bb_ + 256 + 2 * cp) = make_float2(rs0, rs1); *(float2*)(bb_ + 320 + 2 * cp) = make_float2(vs0, vs1); } } while (0)
        SCAN_LOAD(0); SCAN_PREP(0);
        if (NCH > 1) SCAN_LOAD(1);
        LAS float* tscr = (LAS float*)((LAS unsigned char*)lds + 98304 + (w - 4) * 8448);
        f32x4 tv[8]; int tit = -1; const int pw = sbi * 4 + (w - 4);
        __syncthreads();
        for (int n = 0; n < NCH; ++n) {
            if (!SAMPLE && tit >= 0) late_item_finish(a, tit, lane, tv, tscr);
            if (!SAMPLE) { tit = pw + 512 * n; if (tit < I_O + I_UP + I_DN) late_item_load(a, tit, lane, tv); else tit = -1; }
            if (n + 1 < NCH) { SCAN_PREP(n + 1); if (n + 2 < NCH) SCAN_LOAD(n + 2); }
            __syncthreads();
        }
        if (!SAMPLE && tit >= 0) late_item_finish(a, tit, lane, tv, tscr);
#undef SCAN_LOAD
#undef SCAN_PREP
    }
}

__device__ __forceinline__ void phase_gn(const Args& a) {
    const int tid = threadIdx.x, lane = tid & 63, wave = tid >> 6;
    const int gw = blockIdx.x * 8 + wave, NGW = gridDim.x * 8;
    unsigned char* ws = a.ws;
    const bf16_t* Gt = (const bf16_t*)(ws + WS_G); bf16_t* YM = (bf16_t*)(ws + WS_YMIX); const bf16_t* BV = (const bf16_t*)a.out;
    for (int item = gw; item < MR * 16; item += NGW) {
        const int row = item >> 4, h = item & 15, ch = h * 64 + lane;
        const float y = bf2f(YM[(size_t)row * DM + ch]);
        const float bv = bf2f(BV[(size_t)row * 1024 + ch]), g = bf2f(Gt[(size_t)row * 1024 + ch]);
        const float mean = wave_sum(y) * (1.f / 64.f); const float d = y - mean;
        const float var = wave_sum(d * d) * (1.f / 64.f); const float rstd = rsqrtf(var + 64e-5f);
        const float o = (d * rstd * a.in[17][ch] + a.in[18][ch] + bv) * g;
        YM[(size_t)row * DM + ch] = (bf16_t)f2bf(o);
    }
}

__device__ __forceinline__ int crow(int r, int hi) { return (r & 3) + 8 * (r >> 2) + 4 * hi; }
__device__ __forceinline__ void attn_unit(const Args& a, unsigned char* lds, int bh, int qb) {
    const int tid = threadIdx.x, lane = tid & 63, w = tid >> 6, r32 = lane & 31, hi = lane >> 5;
    const int b = bh >> 4, h = bh & 15;
    unsigned char* ws = a.ws;
    const bf16_t* Q = (const bf16_t*)(ws + WS_Q); const bf16_t* KB = (const bf16_t*)(ws + WS_KB); const bf16_t* VT = (const bf16_t*)(ws + WS_VT);
    const bf16_t* KE = (const bf16_t*)(ws + WS_KE); const bf16_t* OG = (const bf16_t*)(ws + WS_OG); bf16_t* YM = (bf16_t*)(ws + WS_YMIX);
    bf16_t* Kt = (bf16_t*)lds;
    bf16_t* Vt = (bf16_t*)(lds + 18432);
    bf16_t* Et = (bf16_t*)(lds + 18432 + 17408);
    const size_t tokbase = (size_t)b * TP;
    const int q0 = qb * 256 + w * 32;
    bf16x8 qf[4];
    { const bf16_t* qp = Q + (tokbase + q0 + r32) * 1024 + h * 64 + hi * 8;
#pragma unroll
      for (int s = 0; s < 4; ++s) qf[s] = *(const bf16x8*)(qp + 16 * s); }
    bf16x8 qx = (bf16x8){0, 0, 0, 0, 0, 0, 0, 0};
    if (hi == 0) { qx[0] = (short)0x3F80; qx[1] = (short)0x3F80; qx[2] = (short)0x3F80; }
    f32x16 ot0, ot1;
#pragma unroll
    for (int r = 0; r < 16; ++r) { ot0[r] = 0.f; ot1[r] = 0.f; }
    float mrun = -INFINITY, lrun = 0.f;
    const int NT = 4 * (qb + 1);
    const int srow = tid >> 3, sch = tid & 7;
    const bf16_t* kg = KB + (tokbase + srow) * 1024 + h * 64 + sch * 8;
    const bf16_t* vg = VT + ((size_t)bh * 64 + srow) * TP + sch * 8;
    const bf16_t* eg = KE + ((size_t)bh * TP + (tid & 63)) * 4;
    u32x4 kreg, vreg; u32x2 ereg = (u32x2){0u, 0u};
#define ATT_LOAD(t) do { kreg = *(const u32x4*)(kg + (size_t)(t) * 64 * 1024); vreg = *(const u32x4*)(vg + (t) * 64); if (tid < 64) ereg = *(const u32x2*)(eg + (t) * 64 * 4); } while (0)
#define ATT_WRITE(bufi) do { *(u32x4*)(Kt + (bufi) * 4608 + srow * 72 + sch * 8) = kreg; \
        *(u32x2*)(Vt + (bufi) * 4352 + srow * 68 + sch * 8) = (u32x2){vreg.x, vreg.y}; *(u32x2*)(Vt + (bufi) * 4352 + srow * 68 + sch * 8 + 4) = (u32x2){vreg.z, vreg.w}; \
        if (tid < 64) *(u32x2*)(Et + (bufi) * 256 + tid * 4) = ereg; } while (0)
    ATT_LOAD(0); ATT_WRITE(0);
    __syncthreads();
    for (int t = 0; t < NT; ++t) {
        const int cur = t & 1;
        if (t + 1 < NT) ATT_LOAD(t + 1);
        if (64 * t <= q0 + 31) {
            const bf16_t* kb_ = Kt + cur * 4608; const bf16_t* vb_ = Vt + cur * 4352; const bf16_t* eb_ = Et + cur * 256;
            f32x16 st0, st1;
#pragma unroll
            for (int r = 0; r < 16; ++r) { st0[r] = 0.f; st1[r] = 0.f; }
#pragma unroll
            for (int s = 0; s < 4; ++s) {
                const bf16x8 k0 = *(const bf16x8*)(kb_ + r32 * 72 + 16 * s + 8 * hi), k1 = *(const bf16x8*)(kb_ + (32 + r32) * 72 + 16 * s + 8 * hi);
                st0 = __builtin_amdgcn_mfma_f32_32x32x16_bf16(k0, qf[s], st0, 0, 0, 0);
                st1 = __builtin_amdgcn_mfma_f32_32x32x16_bf16(k1, qf[s], st1, 0, 0, 0);
            }
            {
                bf16x8 e0 = (bf16x8){0, 0, 0, 0, 0, 0, 0, 0}, e1 = e0;
                if (hi == 0) {
                    const u32x2 x0 = *(const u32x2*)(eb_ + r32 * 4), x1 = *(const u32x2*)(eb_ + (32 + r32) * 4);
                    e0[0] = (short)(x0.x & 0xffffu); e0[1] = (short)(x0.x >> 16); e0[2] = (short)(x0.y & 0xffffu);
                    e1[0] = (short)(x1.x & 0xffffu); e1[1] = (short)(x1.x >> 16); e1[2] = (short)(x1.y & 0xffffu);
                }
                st0 = __builtin_amdgcn_mfma_f32_32x32x16_bf16(e0, qx, st0, 0, 0, 0);
                st1 = __builtin_amdgcn_mfma_f32_32x32x16_bf16(e1, qx, st1, 0, 0, 0);
            }
            if (64 * t + 63 > q0) {
                const int qi = q0 + r32;
#pragma unroll
                for (int r = 0; r < 16; ++r) { const int kv = 64 * t + crow(r, hi); if (kv > qi) st0[r] = -INFINITY; if (kv + 32 > qi) st1[r] = -INFINITY; }
            }
            float mx = fmaxf(st0[0], st1[0]);
#pragma unroll
            for (int r = 1; r < 16; ++r) mx = fmaxf(mx, fmaxf(st0[r], st1[r]));
            mx = fmaxf(mx, __shfl_xor(mx, 32));
            const float mnew = fmaxf(mrun, mx);
            const float alpha = __builtin_amdgcn_exp2f(mrun - mnew);
            mrun = mnew;
            float rs = 0.f;
#pragma unroll
            for (int r = 0; r < 16; ++r) { st0[r] = __builtin_amdgcn_exp2f(st0[r] - mnew); st1[r] = __builtin_amdgcn_exp2f(st1[r] - mnew); rs += st0[r] + st1[r]; }
            lrun = lrun * alpha + rs;
#pragma unroll
            for (int r = 0; r < 16; ++r) { ot0[r] *= alpha; ot1[r] *= alpha; }
#pragma unroll
            for (int sp = 0; sp < 4; ++sp) {
                const int base = 8 * (sp & 1);
                u32x4 pw;
                if (sp < 2) { pw.x = cvt_pk_bf16(st0[base + 0], st0[base + 1]); pw.y = cvt_pk_bf16(st0[base + 2], st0[base + 3]); pw.z = cvt_pk_bf16(st0[base + 4], st0[base + 5]); pw.w = cvt_pk_bf16(st0[base + 6], st0[base + 7]); }
                else        { pw.x = cvt_pk_bf16(st1[base + 0], st1[base + 1]); pw.y = cvt_pk_bf16(st1[base + 2], st1[base + 3]); pw.z = cvt_pk_bf16(st1[base + 4], st1[base + 5]); pw.w = cvt_pk_bf16(st1[base + 6], st1[base + 7]); }
                const bf16x8 pf = __builtin_bit_cast(bf16x8, pw);
                {
                    const bf16_t* vp = vb_ + r32 * 68 + 16 * sp + 4 * hi;
                    const u32x2 lo = *(const u32x2*)vp, hi2 = *(const u32x2*)(vp + 8);
                    const bf16x8 vf = __builtin_bit_cast(bf16x8, (u32x4){lo.x, lo.y, hi2.x, hi2.y});
                    ot0 = __builtin_amdgcn_mfma_f32_32x32x16_bf16(vf, pf, ot0, 0, 0, 0);
                }
                {
                    const bf16_t* vp = vb_ + (32 + r32) * 68 + 16 * sp + 4 * hi;
                    const u32x2 lo = *(const u32x2*)vp, hi2 = *(const u32x2*)(vp + 8);
                    const bf16x8 vf = __builtin_bit_cast(bf16x8, (u32x4){lo.x, lo.y, hi2.x, hi2.y});
                    ot1 = __builtin_amdgcn_mfma_f32_32x32x16_bf16(vf, pf, ot1, 0, 0, 0);
                }
            }
        }
        if (t + 1 < NT) ATT_WRITE(cur ^ 1);
        __syncthreads();
    }
#undef ATT_LOAD
#undef ATT_WRITE
    {
        const float lt = lrun + __shfl_xor(lrun, 32); const float inv = 1.0f / lt;
        float ss = 0.f;
#pragma unroll
        for (int r = 0; r < 16; ++r) { ot0[r] *= inv; ot1[r] *= inv; ss += ot0[r] * ot0[r] + ot1[r] * ot1[r]; }
        ss += __shfl_xor(ss, 32);
        const float rinv = rsqrtf(ss * (1.f / 64.f) + 1e-6f);
        const size_t row = tokbase + q0 + r32;
        const float* fog = a.in[20];
#pragma unroll
        for (int dh = 0; dh < 2; ++dh)
#pragma unroll
            for (int g = 0; g < 4; ++g) {
                const int col = h * 64 + 32 * dh + 8 * g + 4 * hi;
                const u32x2 og = *(const u32x2*)(OG + row * 1024 + col); const f32x4 gg = *(const f32x4*)(fog + col);
                float o[4];
#pragma unroll
                for (int j = 0; j < 4; ++j) o[j] = (dh == 0 ? ot0[4 * g + j] : ot1[4 * g + j]) * rinv * gg[j];
                u32x2 wv; wv.x = pk2(o[0] * bflo(og.x), o[1] * bfhi(og.x)); wv.y = pk2(o[2] * bflo(og.y), o[3] * bfhi(og.y));
                *(u32x2*)(YM + row * DM + 1024 + col) = wv;
            }
    }
}

__device__ __forceinline__ void sattn_unit(const Args& a, unsigned char* lds, int bh) {
    const int tid = threadIdx.x, lane = tid & 63, w = tid >> 6;
    const int b = bh >> 4, h = bh & 15;
    unsigned char* ws = a.ws;
    const bf16_t* Q = (const bf16_t*)(ws + WS_Q); const bf16_t* OG = (const bf16_t*)(ws + WS_OG); bf16_t* YM = (bf16_t*)(ws + WS_YMIX);
    const float* ck = a.in[2]; const float* cv = a.in[3]; const float* clf = a.in[4];
    float* qs = (float*)lds;
    float* cb = qs + 1024;
    float* sc = cb + 1088;
    float* red = sc + 16640;
    for (int i = tid; i < 1024; i += 512) { const int q = i >> 6, d = i & 63; qs[i] = bf2f(Q[(size_t)(MP + b * 16 + q) * 1024 + h * 64 + d]); }
    if (w == 0) {
        const int e0 = lane * 17; float loc = 0.f;
        for (int i = 0; i < 17; ++i) { const int e = e0 + i; if (e < 1040) loc += (e < 1024) ? clf[((size_t)b * 1024 + e) * 16 + h] : a.out[OFF_SLOGF + (size_t)(b * 16 + e - 1024) * 16 + h]; }
        float inc = loc;
#pragma unroll
        for (int o = 1; o < 64; o <<= 1) { const float n = __shfl_up(inc, o); if (lane >= o) inc += n; }
        float run = inc - loc;
        for (int i = 0; i < 17; ++i) { const int e = e0 + i; if (e < 1040) { run += (e < 1024) ? clf[((size_t)b * 1024 + e) * 16 + h] : a.out[OFF_SLOGF + (size_t)(b * 16 + e - 1024) * 16 + h]; cb[e] = -run * LOG2E; } }
    }
    __syncthreads();
#pragma unroll 1
    for (int it = 0; it < 3; ++it) {
        const int j = tid + 512 * it;
        if (j < 1040) {
            const float* kp = (j < 1024) ? ck + (((size_t)b * 1024 + j) * 16 + h) * 64 : a.out + OFF_SK + ((size_t)(b * 16 + j - 1024) * 16 + h) * 64;
            f32x4 kv[16];
#pragma unroll
            for (int i = 0; i < 16; ++i) kv[i] = *(const f32x4*)(kp + 4 * i);
            const float bias = cb[j];
#pragma unroll 1
            for (int q = 0; q < 16; ++q) {
                const f32x4* qp = (const f32x4*)(qs + q * 64);
                float d0 = 0.f, d1 = 0.f;
#pragma unroll
                for (int i = 0; i < 16; i += 2) { const f32x4 x = qp[i], y = qp[i + 1];
                    d0 += x[0] * kv[i][0] + x[1] * kv[i][1] + x[2] * kv[i][2] + x[3] * kv[i][3];
                    d1 += y[0] * kv[i + 1][0] + y[1] * kv[i + 1][1] + y[2] * kv[i + 1][2] + y[3] * kv[i + 1][3]; }
                float sv = d0 + d1 + bias;
                if (j >= 1024 && j - 1024 > q) sv = -INFINITY;
                sc[q * 1040 + j] = sv;
            }
        }
    }
    __syncthreads();
    for (int qq = 0; qq < 2; ++qq) {
        float* sr = sc + (2 * w + qq) * 1040;
        float mx = -INFINITY;
        for (int j = lane; j < 1040; j += 64) mx = fmaxf(mx, sr[j]);
        mx = wave_max(mx);
        float sum = 0.f;
        for (int j = lane; j < 1040; j += 64) { const float p = __builtin_amdgcn_exp2f(sr[j] - mx); sr[j] = p; sum += p; }
        sum = wave_sum(sum);
        const float inv = 1.0f / sum;
        for (int j = lane; j < 1040; j += 64) sr[j] *= inv;
    }
    __syncthreads();
    {
        float acc[16];
#pragma unroll
        for (int q = 0; q < 16; ++q) acc[q] = 0.f;
        const float* vbase = cv + (((size_t)b * 1024) * 16 + h) * 64 + lane;
#pragma unroll 16
        for (int j = w; j < 1024; j += 8) {
            const float vv = vbase[(size_t)j * 1024];
#pragma unroll
            for (int q = 0; q < 16; ++q) acc[q] = fmaf(sc[q * 1040 + j], vv, acc[q]);
        }
        for (int j = 1024 + w; j < 1040; j += 8) {
            const float vv = a.out[OFF_SV + ((size_t)(b * 16 + j - 1024) * 16 + h) * 64 + lane];
#pragma unroll
            for (int q = 0; q < 16; ++q) acc[q] = fmaf(sc[q * 1040 + j], vv, acc[q]);
        }
#pragma unroll
        for (int q = 0; q < 16; ++q) red[(w * 16 + q) * 64 + lane] = acc[q];
    }
    __syncthreads();
    for (int pass = 0; pass < 2; ++pass) {
        const int q = w + 8 * pass;
        float o = 0.f;
#pragma unroll
        for (int ww = 0; ww < 8; ++ww) o += red[(ww * 16 + q) * 64 + lane];
        const float ss = wave_sum(o * o);
        const float rinv = rsqrtf(ss * (1.f / 64.f) + 1e-6f);
        const size_t row = (size_t)(MP + b * 16 + q); const int col = h * 64 + lane;
        const float y = o * rinv * a.in[20][col] * bf2f(OG[row * 1024 + col]);
        YM[row * DM + 1024 + col] = (bf16_t)f2bf(y);
    }
    __syncthreads();
}

__device__ __forceinline__ int next_work(unsigned* ctr, unsigned char* lds) {
    volatile unsigned* wordp = (volatile unsigned*)(lds + LDS_WORD_OFF);
    if (threadIdx.x == 0) *wordp = __hip_atomic_fetch_add(ctr, 1u, __ATOMIC_RELAXED, __HIP_MEMORY_SCOPE_AGENT);
    __syncthreads();
    const int v = (int)*wordp;
    __syncthreads();
    return v;
}

#define GAS __attribute__((address_space(1)))
#define RLX_AGENT __ATOMIC_RELAXED, __HIP_MEMORY_SCOPE_AGENT
#define XB_TMO      128
#define XB_XCNT(j)  (256  + 64 * (j))
#define XB_XSUB(j)  (1280 + 64 * (j))
#define XB_XGEN(j)  (2304 + 64 * (j))
#define XB_TOP      3328
#define XB_TOPGEN   3392
#define XCD_BAR_WORDS 3456
#define XB_SPIN_CAP (1u << 18)

__device__ __forceinline__ unsigned xb_ld(unsigned* p)              { return __hip_atomic_load(p, __ATOMIC_RELAXED, __HIP_MEMORY_SCOPE_AGENT); }
__device__ __forceinline__ unsigned xb_add(unsigned* p, unsigned v) { return __hip_atomic_fetch_add(p, v, __ATOMIC_RELAXED, __HIP_MEMORY_SCOPE_AGENT); }
__device__ __forceinline__ unsigned xb_xcc_id() { return (unsigned)__builtin_amdgcn_s_getreg((3 << 11) | 20) & 0xFu; }
#define XB_SPIN(cond, bar) do { unsigned _sp = 0; while (cond) { __builtin_amdgcn_s_sleep(1); \
    if ((++_sp & 255u) == 0u) { if (xb_ld(&(bar)[XB_TMO])) break; if (_sp > XB_SPIN_CAP) { atomicAdd(&(bar)[XB_TMO], 1u); break; } } } } while (0)

struct XcdBarrier {
    unsigned* bar; unsigned x;
    volatile LAS unsigned* st;
};

__device__ __forceinline__ XcdBarrier xcd_barrier_post(unsigned* bar, volatile LAS unsigned* st) {
    XcdBarrier b; b.bar = bar; b.x = xb_xcc_id(); b.st = st;
    if (threadIdx.x == 0) (void)xb_add(&bar[XB_XCNT(b.x)], 1u);
    return b;
}
__device__ __forceinline__ void xcd_barrier_complete(unsigned* bar, unsigned x, unsigned& nloc, unsigned& nx) {
    const unsigned G = gridDim.x * gridDim.y * gridDim.z;
    unsigned sum, cnt, mine, sp = 0u;
    for (;;) {
        sum = 0u; cnt = 0u; mine = 0u;
#pragma unroll
        for (unsigned j = 0; j < 16; ++j) { const unsigned c = xb_ld(&bar[XB_XCNT(j)]); sum += c; cnt += (c > 0u) ? 1u : 0u; mine = (j == x) ? c : mine; }
        if (sum == G) break;
        __builtin_amdgcn_s_sleep(1);
        if ((++sp & 255u) == 0u) { if (xb_ld(&bar[XB_TMO])) break; if (sp > XB_SPIN_CAP) { atomicAdd(&bar[XB_TMO], 1u); break; } }
    }
    nloc = mine > 0u ? mine : 1u; nx = cnt > 0u ? cnt : 1u;
}

__device__ __forceinline__ void xcd_barrier(const XcdBarrier& b) {
    asm volatile("s_waitcnt vmcnt(0)" ::: "memory");
    __syncthreads();
    if (threadIdx.x == 0) {
        unsigned* bar = b.bar;
        __builtin_amdgcn_s_waitcnt(0);
        unsigned nloc = b.st[0], nx = b.st[1];
        if (nloc == 0u) { xcd_barrier_complete(bar, b.x, nloc, nx); b.st[0] = nloc; b.st[1] = nx; }
        const unsigned old = xb_add(&bar[XB_XSUB(b.x)], 1u);
        const unsigned gen = old / nloc;
        if (old + 1u == (gen + 1u) * nloc) {
            __builtin_amdgcn_fence(__ATOMIC_RELEASE, "agent");
            asm volatile("s_waitcnt vmcnt(0)" ::: "memory");
            const unsigned og = xb_add(&bar[XB_TOP], 1u);
            const unsigned tg = og / nx;
            if (og + 1u == (tg + 1u) * nx) xb_add(&bar[XB_TOPGEN], 1u);
            else XB_SPIN(xb_ld(&bar[XB_TOPGEN]) == tg, bar);
            __builtin_amdgcn_fence(__ATOMIC_ACQUIRE, "agent");
            xb_add(&bar[XB_XGEN(b.x)], 1u);
            asm volatile("s_waitcnt vmcnt(0)" ::: "memory");
        } else {
            XB_SPIN(xb_ld(&bar[XB_XGEN(b.x)]) == gen, bar);
            __builtin_amdgcn_fence(__ATOMIC_ACQUIRE, "agent");
            asm volatile("s_waitcnt vmcnt(0)" ::: "memory");
        }
    }
    __syncthreads();
}

__global__ void __launch_bounds__(512, 2) mk_fwd(Args a) {
    extern __shared__ __attribute__((aligned(16))) unsigned char lds[];
    LAS unsigned char* ldsl = (LAS unsigned char*)lds;
    const int lo = a.ph_lo, hi = a.ph_hi, G = gridDim.x;
    unsigned char* ws = a.ws;
#ifndef PH_MASK
#define PH_MASK 0x7ff
#endif
#define IN(k) (((PH_MASK >> (k)) & 1) && lo <= (k) && (k) < hi)
    if (threadIdx.x < 4) ((LAS unsigned*)(ldsl + LDS_BARW_OFF))[threadIdx.x] = 0u;
    __syncthreads();
    XcdBarrier bar = xcd_barrier_post((unsigned*)(ws + WS_CTL) + CW_BAR, (volatile LAS unsigned*)(ldsl + LDS_BARW_OFF));
    if (a.ph_hi > 1000) cg::this_grid().sync();
#define SEAM(k) do { if (IN(k) && IN((k) + 1)) xcd_barrier(bar); } while (0)
    if (IN(0)) { phase0(a, ldsl); }
    SEAM(0);
    if (IN(1)) {
        Gemm g{(const bf16_t*)(ws + WS_XB), (const bf16_t*)(ws + WS_WIN), MT, NIN, DM}; StaticOrder S; S.init(MT, NIN, DM, G, (int)blockIdx.x);
        EpiIn E{(bf16_t*)(ws + WS_PR), (bf16_t*)(ws + WS_Q), (bf16_t*)(ws + WS_KB), (bf16_t*)(ws + WS_VT), (bf16_t*)(ws + WS_OG), a.out, a.in[19]};
        gemm_phase<EpiIn, StaticOrder, true, true>(ldsl, g, S, E);
    }
    SEAM(1);
    if (IN(2)) { if (blockIdx.x < 2) phase2_cumsum(a, lds, (int)blockIdx.x); phase2(a); }
    SEAM(2);
    if (IN(3)) {
        Gemm g{(const bf16_t*)(ws + WS_LIN), (const bf16_t*)(ws + WS_LORA), MT, NL, KL}; StaticOrder S; S.init(MT, NL, KL, G, (int)blockIdx.x);
        EpiLora E{(float*)(ws + WS_W), (bf16_t*)(ws + WS_ALR), (bf16_t*)(ws + WS_G), a.in[9], a.in[11]};
        gemm_phase<EpiLora, StaticOrder, true, true>(ldsl, g, S, E);
    }
    SEAM(3);
    if (IN(4)) {
        unsigned* ctr = (unsigned*)(ws + WS_CTL) + 128 * a.rep;
        const int pm_ = a.pad ? a.pad : 7;
        if (blockIdx.x < 128) { if (pm_ & 1) { const int sb = (int)blockIdx.x; const int bh = (sb & 7) * 4 + ((sb >> 3) >> 2); scan_unit<false>(a, lds, bh >> 4, bh & 15, (sb >> 3) & 3, sb); } }
        else if (pm_ & 2) { for (;;) { const int i = next_work(ctr, lds); if (i >= 512) break; attn_unit(a, lds, i & 31, 15 - (i >> 5)); } }
        if (pm_ & 4) for (;;) { const int j = next_work(ctr + 64, lds); if (j >= 640) break;
            if (j < 128) sattn_unit(a, lds, j); else { const int u = j - 128; scan_unit<true>(a, lds, u >> 6, (u >> 2) & 15, u & 3, 0); } }
    }
    SEAM(4);
    if (IN(5)) { phase_gn(a); }
    SEAM(5);
    if (IN(6)) {
        Gemm g{(const bf16_t*)(ws + WS_YMIX), (const bf16_t*)(ws + WS_WO), MT, DM, DM}; SplitOrder S; S.init(DM, DM, G, (int)blockIdx.x, 512);
        EpiRes E{a.in[0], nullptr, a.out, (float*)(ws + WS_SLAB1), 512};
        gemm_phase<EpiRes, SplitOrder, true, true>(ldsl, g, S, E);
    }
    SEAM(6);
    if (IN(7)) { ln_phase(a.out, a.in[22], a.in[23], (bf16_t*)(ws + WS_HB), a.in[1], (const float*)(ws + WS_SLAB1), 4); }
    SEAM(7);
    if (IN(8)) {
        Gemm g{(const bf16_t*)(ws + WS_HB), (const bf16_t*)(ws + WS_WUP), MT, DFF, DM}; StaticOrder S; S.init(MT, DFF, DM, G, (int)blockIdx.x);
        EpiUp E{(bf16_t*)(ws + WS_U)};
        gemm_phase<EpiUp, StaticOrder, true, true>(ldsl, g, S, E);
    }
    SEAM(8);
    if (IN(9)) {
        Gemm g{(const bf16_t*)(ws + WS_U), (const bf16_t*)(ws + WS_WDN), MT, DM, DFF}; SplitOrder S; S.init(DM, DFF, G, (int)blockIdx.x, 1024);
        EpiRes E{nullptr, (const bf16_t*)(ws + WS_HB), a.out, (float*)(ws + WS_SLAB2), 1024};
        gemm_phase<EpiRes, SplitOrder, true, true>(ldsl, g, S, E);
    }
    SEAM(9);
    if (IN(10)) { ln_phase(a.out, a.in[26], a.in[27], nullptr, a.out + OFF_YS, (const float*)(ws + WS_SLAB2), 8); }
#undef IN
#undef SEAM
}
}

extern "C" void kernel_launch(void* const* d_in, const int* in_sizes, int n_in, void* d_out, int out_size, void* d_ws, size_t ws_size, hipStream_t stream) {
    using namespace pg8;
    static int grid = 0;
    if (grid == 0) {
        if (n_in != 28 || (size_t)out_size != OUT_TOTAL || ws_size < WS_END) { fprintf(stderr, "kernel_launch: unexpected problem (n_in %d, out %d, ws %zu); nothing launched\n", n_in, out_size, ws_size); grid = -1; return; }
        int dev = 0, cus = 0, per_cu = 0;
        if (hipGetDevice(&dev) != hipSuccess || hipDeviceGetAttribute(&cus, hipDeviceAttributeMultiprocessorCount, dev) != hipSuccess) { grid = -1; return; }
        if (hipFuncSetAttribute((const void*)mk_fwd, hipFuncAttributeMaxDynamicSharedMemorySize, LDS_BYTES) != hipSuccess) { fprintf(stderr, "kernel_launch: hipFuncSetAttribute failed\n"); grid = -1; return; }
        if (hipOccupancyMaxActiveBlocksPerMultiprocessor(&per_cu, (const void*)mk_fwd, 512, LDS_BYTES) != hipSuccess || per_cu < 1) { fprintf(stderr, "kernel_launch: occupancy query says %d\n", per_cu); per_cu = 1; }
        (void)hipGetLastError();
        grid = cus;
    }
    if (grid < 0) return;
    if (hipMemsetAsync((char*)d_ws + WS_CTL, 0, 65536, stream) != hipSuccess) { fprintf(stderr, "kernel_launch: hipMemsetAsync failed\n"); return; }
    Args a{};
    for (int i = 0; i < 28; ++i) a.in[i] = (const float*)d_in[i];
    a.out = (float*)d_out; a.ws = (unsigned char*)d_ws;
#if ONE_LAUNCH
    a.ph_lo = 0; a.ph_hi = NPH;
    void* args[] = {&a};
    hipError_t e = hipLaunchCooperativeKernel((const void*)mk_fwd, dim3(grid), dim3(512), args, LDS_BYTES, stream);
    if (e != hipSuccess) fprintf(stderr, "kernel_launch: cooperative launch failed: %s (grid %d)\n", hipGetErrorString(e), grid);
#else
#ifndef PROBE_DUP
#define PROBE_DUP -1
#endif
#ifndef PROBE_MODE
#define PROBE_MODE 0
#endif
    for (int p = 0; p < NPH; ++p) { a.ph_lo = p; a.ph_hi = p + 1; a.rep = 0; a.pad = 0; hipLaunchKernelGGL(mk_fwd, dim3(grid), dim3(512), LDS_BYTES, stream, a);
        if (p == PROBE_DUP) { a.rep = 1; a.pad = PROBE_MODE; hipLaunchKernelGGL(mk_fwd, dim3(grid), dim3(512), LDS_BYTES, stream, a); } }
#endif
}
```
